# Optimizing an MI355X kernel written in HIP

```python
import jax, jax.numpy as jnp
from jax import lax
import numpy as np

D_MODEL = 1024
BATCH = 8
SEQ = 2048
DEPTH = 1

CHUNK = 64
N_MEM = 256
HEAD_DIM = 64
D_MIX = D_MODEL
FOX_HEADS = D_MIX // 2 // HEAD_DIM
CHK_HEADS = D_MIX // 2 // HEAD_DIM
D_FOX = FOX_HEADS * HEAD_DIM
D_CHK = CHK_HEADS * HEAD_DIM
LEFT_CHUNKS = 8
BAND = (LEFT_CHUNKS + 1) * CHUNK
MAX_REL = 128
N_REL = 2 * MAX_REL + 1
Q_BLOCK = 128
MEM_HEADS = 4
MEM_HEAD_DIM = D_MODEL // MEM_HEADS
D_FF = 4 * D_MODEL
EPS = 1e-6
D_IN = 3 * D_FOX + FOX_HEADS + 3 * D_CHK

kernel_name = 'hybrid_fox_chunkrel_memxattn_block'


def rmsnorm(x, g):
    xf = x.astype(jnp.float32)
    y = xf * lax.rsqrt(jnp.mean(xf * xf, axis=-1, keepdims=True) + EPS) * g.astype(jnp.float32)
    return y.astype(x.dtype)


def forgetting_attention(q, k, v, f_logit):
    S = q.shape[1]
    Dh = q.shape[-1]
    scale = Dh ** -0.5
    logf = jax.nn.log_sigmoid(f_logit.astype(jnp.float32))
    c = jnp.cumsum(logf, axis=1).transpose(0, 2, 1)
    pos = jnp.arange(S)
    outs = []
    for i in range(S // Q_BLOCK):
        q0, q1 = i * Q_BLOCK, (i + 1) * Q_BLOCK
        qb = q[:, q0:q1]
        kb = k[:, :q1]
        vb = v[:, :q1]
        logits = jnp.einsum('bqhd,bkhd->bhqk', qb, kb).astype(jnp.float32) * scale
        logits = logits + c[:, :, q0:q1, None] - c[:, :, None, :q1]
        causal = pos[q0:q1, None] >= pos[None, :q1]
        logits = jnp.where(causal[None, None], logits, -jnp.inf)
        p = jax.nn.softmax(logits, axis=-1).astype(v.dtype)
        outs.append(jnp.einsum('bhqk,bkhd->bqhd', p, vb))
    return jnp.concatenate(outs, axis=1)


def _rel_index():
    i = np.arange(CHUNK)[:, None]
    m = np.arange(BAND)[None, :]
    rel = i + LEFT_CHUNKS * CHUNK - m
    return np.clip(rel, -MAX_REL, MAX_REL) + MAX_REL


def chunked_relpos_attention(q, k, v, rel_table):
    B, S, H, Dh = q.shape
    NC = S // CHUNK
    scale = Dh ** -0.5
    qc = q.reshape(B, NC, CHUNK, H, Dh)
    pad = ((0, 0), (LEFT_CHUNKS * CHUNK, 0), (0, 0), (0, 0))
    kp = jnp.pad(k, pad).reshape(B, NC + LEFT_CHUNKS, CHUNK, H, Dh)
    vp = jnp.pad(v, pad).reshape(B, NC + LEFT_CHUNKS, CHUNK, H, Dh)
    kband = jnp.concatenate([kp[:, j:j + NC] for j in range(LEFT_CHUNKS + 1)], axis=2)
    vband = jnp.concatenate([vp[:, j:j + NC] for j in range(LEFT_CHUNKS + 1)], axis=2)
    bias = rel_table.astype(jnp.float32)[:, _rel_index()]
    key_pos = jnp.arange(NC)[:, None] * CHUNK + jnp.arange(BAND)[None, :] - LEFT_CHUNKS * CHUNK
    valid = key_pos >= 0
    logits = jnp.einsum('bcqhd,bckhd->bhcqk', qc, kband).astype(jnp.float32) * scale
    logits = logits + bias[None, :, None]
    logits = jnp.where(valid[None, None, :, None, :], logits, -jnp.inf)
    p = jax.nn.softmax(logits, axis=-1).astype(v.dtype)
    out = jnp.einsum('bhcqk,bckhd->bcqhd', p, vband)
    return out.reshape(B, S, H, Dh)


def memory_cross_attention(h, mem_n, w_mq, w_mk, w_mv, w_mo):
    B, S, _ = h.shape
    M = mem_n.shape[1]
    q = (h @ w_mq).reshape(B, S, MEM_HEADS, MEM_HEAD_DIM)
    k = (mem_n @ w_mk).reshape(B, M, MEM_HEADS, MEM_HEAD_DIM)
    v = (mem_n @ w_mv).reshape(B, M, MEM_HEADS, MEM_HEAD_DIM)
    logits = jnp.einsum('bshd,bmhd->bhsm', q, k).astype(jnp.float32) * (MEM_HEAD_DIM ** -0.5)
    p = jax.nn.softmax(logits, axis=-1).astype(v.dtype)
    o = jnp.einsum('bhsm,bmhd->bshd', p, v).reshape(B, S, D_MODEL)
    return o @ w_mo


def setup_inputs(seed: int = 0) -> dict:
    key = jax.random.key(seed)
    ks = jax.random.split(key, 24)
    f32 = jnp.float32

    def w(k, shape, fan_in):
        return jax.random.normal(k, shape, f32) * fan_in ** -0.5

    def gain(k, n):
        return 1.0 + 0.05 * jax.random.normal(k, (DEPTH, n), f32)

    return {
        'x': jax.random.normal(ks[0], (BATCH, SEQ, D_MODEL), f32),
        'mem': jax.random.normal(ks[1], (BATCH, N_MEM, D_MODEL), f32),
        'w_in': w(ks[2], (DEPTH, D_MODEL, D_IN), D_MODEL),
        'b_fgt': 3.0 + 0.1 * jax.random.normal(ks[3], (DEPTH, FOX_HEADS), f32),
        'rel_bias': 0.2 * jax.random.normal(ks[4], (DEPTH, CHK_HEADS, N_REL), f32),
        'g_fox_out': gain(ks[5], D_FOX),
        'g_chk_out': gain(ks[6], D_CHK),
        'w_out': w(ks[7], (DEPTH, D_MIX, D_MODEL), D_MIX),
        'g_mix_pre': gain(ks[8], D_MODEL),
        'g_mix_post': gain(ks[9], D_MODEL),
        'g_mem_kv': gain(ks[10], D_MODEL),
        'w_mq': w(ks[11], (DEPTH, D_MODEL, D_MODEL), D_MODEL),
        'w_mk': w(ks[12], (DEPTH, D_MODEL, D_MODEL), D_MODEL),
        'w_mv': w(ks[13], (DEPTH, D_MODEL, D_MODEL), D_MODEL),
        'w_mo': w(ks[14], (DEPTH, D_MODEL, D_MODEL), D_MODEL),
        'g_mem_pre': gain(ks[15], D_MODEL),
        'g_mem_post': gain(ks[16], D_MODEL),
        'w_ff1': w(ks[17], (DEPTH, D_MODEL, D_FF), D_MODEL),
        'w_ff2': w(ks[18], (DEPTH, D_FF, D_MODEL), D_FF),
        'g_ff_pre': gain(ks[19], D_MODEL),
        'g_ff_post': gain(ks[20], D_MODEL),
    }


def reference(x, mem, w_in, b_fgt, rel_bias, g_fox_out, g_chk_out, w_out, g_mix_pre, g_mix_post,
              g_mem_kv, w_mq, w_mk, w_mv, w_mo, g_mem_pre, g_mem_post,
              w_ff1, w_ff2, g_ff_pre, g_ff_post):
    B, S, _ = x.shape
    for l in range(DEPTH):
        h = rmsnorm(x, g_mix_pre[l])
        proj = h @ w_in[l]
        o0 = 0
        fq = proj[..., o0:o0 + D_FOX]; o0 += D_FOX
        fk = proj[..., o0:o0 + D_FOX]; o0 += D_FOX
        fv = proj[..., o0:o0 + D_FOX]; o0 += D_FOX
        f_logit = proj[..., o0:o0 + FOX_HEADS] + b_fgt[l]; o0 += FOX_HEADS
        cq = proj[..., o0:o0 + D_CHK]; o0 += D_CHK
        ck = proj[..., o0:o0 + D_CHK]; o0 += D_CHK
        cv = proj[..., o0:o0 + D_CHK]
        shp_f = (B, S, FOX_HEADS, HEAD_DIM)
        shp_c = (B, S, CHK_HEADS, HEAD_DIM)
        y_fox = forgetting_attention(fq.reshape(shp_f), fk.reshape(shp_f), fv.reshape(shp_f), f_logit)
        y_chk = chunked_relpos_attention(cq.reshape(shp_c), ck.reshape(shp_c), cv.reshape(shp_c), rel_bias[l])
        y = jnp.concatenate([rmsnorm(y_fox.reshape(B, S, D_FOX), g_fox_out[l]),
                             rmsnorm(y_chk.reshape(B, S, D_CHK), g_chk_out[l])], axis=-1)
        x = x + rmsnorm(y @ w_out[l], g_mix_post[l])
        h = rmsnorm(x, g_mem_pre[l])
        mem_n = rmsnorm(mem, g_mem_kv[l])
        y = memory_cross_attention(h, mem_n, w_mq[l], w_mk[l], w_mv[l], w_mo[l])
        x = x + rmsnorm(y, g_mem_post[l])
        h = rmsnorm(x, g_ff_pre[l])
        y = jnp.square(jax.nn.relu(h @ w_ff1[l])) @ w_ff2[l]
        x = x + rmsnorm(y, g_ff_post[l])
    return x
```

```cpp
#include <hip/hip_runtime.h>
#include <hip/hip_cooperative_groups.h>
#include <cstdio>
#include <cstdint>
namespace cg = cooperative_groups;
namespace pg8 {
#define PG8_LAS __attribute__((address_space(3)))
typedef unsigned short bf16_t;
typedef short bf16x8 __attribute__((ext_vector_type(8)));
typedef float f32x4 __attribute__((ext_vector_type(4)));
typedef unsigned u32x4 __attribute__((ext_vector_type(4)));
constexpr int BM = 256, BK = 64, HALF = 128, HTB = HALF * BK * 2  , STAGE_BYTES = 8 * HTB, NXCD = 8, WGM = 8;

__host__ __device__ __forceinline__ int lds_byte(int r, int c) { const int st = (r >> 4) * 2 + (c >> 5), rr = r & 15, cc = c & 31, ob = rr * 64 + cc * 2; return st * 1024 + (ob ^ (((ob >> 9) & 1) << 5)); }
__host__ __device__ __forceinline__ void stage_rc(int b, int& R, int& C) { const int st = b / 1024, sb = b % 1024, swz = sb ^ (((sb >> 9) & 1) << 5); R = (st >> 1) * 16 + swz / 64; C = (st & 1) * 32 + (swz % 64) / 2; }
__host__ __device__ __forceinline__ int perm32(int rho) { const int n = rho >> 4, i = rho & 15; return 8 * (i >> 2) + 4 * n + (i & 3); }

struct Unit { int pm, pn; };
struct Gemm { const bf16_t* A; const bf16_t* Bt; int M, N, K; };

struct StaticOrder {
    int nM, nN, nwg, G, c;
    __host__ __device__ void init(int M, int N, int G_, int c_) { nM = M / BM; nN = N / BM; nwg = nM * nN; G = G_; c = c_; }
    __host__ __device__ bool next(int i, Unit& u) const {
        const long L = (long)i * G + c; if (L >= nwg) return false;
        int wgid = (int)L; { const int q = nwg / NXCD, r = nwg % NXCD, xcd = wgid % NXCD, off = wgid / NXCD; wgid = (xcd < r ? xcd * (q + 1) : r * (q + 1) + (xcd - r) * q) + off; }
        const int nig = WGM * nN, gid = wgid / nig, fm = gid * WGM, gsz = (nM - fm) < WGM ? (nM - fm) : WGM;
        u.pm = fm + ((wgid % nig) % gsz); u.pn = (wgid % nig) / gsz; return true;
    }
    __device__ __forceinline__ void a_ready(const Unit&) const {}
    __device__ __forceinline__ void done(const Unit&) const {}
};

__device__ __forceinline__ unsigned cvt_pk_bf16(float lo, float hi) { unsigned r; asm volatile("v_cvt_pk_bf16_f32 %0, %1, %2" : "=v"(r) : "v"(lo), "v"(hi)); return r; }
typedef float f32x2 __attribute__((ext_vector_type(2)));
template <int ACT  > struct EpiStore {
    static constexpr bool PERM = true, AFTER_DRAIN = false;
    bf16_t* O; int ldc;
    __device__ __forceinline__ void operator()(const f32x4 (&acc)[2][2][4][2], const Unit& u, int wr, int wc, int fr, int fq) const {
        const int row0 = u.pm * BM + wr * 64 + fr; const int col0 = u.pn * BM + wc * 32 + 8 * fq;
#pragma unroll
        for (int ai = 0; ai < 2; ++ai)
#pragma unroll
            for (int m = 0; m < 4; ++m) { bf16_t* rowp = O + (size_t)(row0 + ai * HALF + m * 16) * ldc + col0;
#pragma unroll
                for (int bj = 0; bj < 2; ++bj) { f32x4 v0 = acc[ai][bj][m][0], v1 = acc[ai][bj][m][1];
                    if (ACT == 2) {
#pragma unroll
                        for (int e = 0; e < 4; ++e) { float a = v0[e] > 0.f ? v0[e] : 0.f; v0[e] = a * a; float b = v1[e] > 0.f ? v1[e] : 0.f; v1[e] = b * b; } }
                    u32x4 w; w.x = cvt_pk_bf16(v0[0], v0[1]); w.y = cvt_pk_bf16(v0[2], v0[3]); w.z = cvt_pk_bf16(v1[0], v1[1]); w.w = cvt_pk_bf16(v1[2], v1[3]);
                    *(u32x4*)(rowp + bj * HALF) = w; } }
    }
};
template <class Epi, class Sched, bool ALIGN_EPI = false, bool SP2 = false>
__device__ __forceinline__ void gemm_phase(PG8_LAS unsigned char* lds, const Gemm g, const Sched& S, const Epi& E) {
    const int tid = threadIdx.x, wid = __builtin_amdgcn_readfirstlane(tid >> 6), lane = tid & 63, wr = wid >> 2, wc = wid & 3, fr = lane & 15, fq = lane >> 4;
    const int K = g.K, nt = K / BK;
    unsigned voffA[2], voffB[2];
#pragma unroll
    for (int i = 0; i < 2; ++i) { int R, C; stage_rc(tid * 16 + i * 8192, R, C); const int Rb = Epi::PERM ? ((R & ~31) + perm32(R & 31)) : R;
        voffA[i] = (unsigned)(R * K + C) * 2u; voffB[i] = (unsigned)(Rb * K + C) * 2u; }
    const size_t kstep = (size_t)(BK * 2);
    const size_t hstep = (size_t)HALF * K * 2;
    const size_t tstep = 2 * hstep;
    const unsigned ldsw = (unsigned)wid * 1024u;
    const int aoff = lds_byte(wr * 64 + fr, fq * 8), boff = lds_byte(wc * 32 + fr, fq * 8);
#define PG8_SA(b, h) (((b) * 2 + (h)) * HTB)
#define PG8_SB(b, h) ((4 + (b) * 2 + (h)) * HTB)
#define PG8_STAGE(bufoff, gbase, voff) do { _Pragma("unroll") for (int _i = 0; _i < 2; ++_i) \
        __builtin_amdgcn_global_load_lds((const unsigned*)((const char*)(gbase) + (voff)[_i]), (PG8_LAS unsigned*)(lds + (bufoff) + ldsw + _i * 8192), 16, 0, 0); } while (0)
#define PG8_LDA(dst, b, h) do { _Pragma("unroll") for (int m = 0; m < 4; ++m) _Pragma("unroll") for (int k = 0; k < 2; ++k) dst[m][k] = *(const PG8_LAS bf16x8*)(lds + PG8_SA(b, h) + aoff + m * 2048 + k * 1024); } while (0)
#define PG8_LDB(dst, b, h) do { _Pragma("unroll") for (int n = 0; n < 2; ++n) _Pragma("unroll") for (int k = 0; k < 2; ++k) dst[n][k] = *(const PG8_LAS bf16x8*)(lds + PG8_SB(b, h) + boff + n * 2048 + k * 1024); } while (0)
#define PG8_MMA(ai, bj, At, Bt) do { __builtin_amdgcn_s_setprio(1); _Pragma("unroll") for (int m = 0; m < 4; ++m) _Pragma("unroll") for (int n = 0; n < 2; ++n) _Pragma("unroll") for (int k = 0; k < 2; ++k) \
        acc[ai][bj][m][n] = __builtin_amdgcn_mfma_f32_16x16x32_bf16(Bt[n][k], At[m][k], acc[ai][bj][m][n], 0, 0, 0); __builtin_amdgcn_s_setprio(0); } while (0)
#define PG8_WAIT_V(n) asm volatile("s_waitcnt vmcnt(" #n ")" ::: "memory")
#define PG8_WAIT_L(n) asm volatile("s_waitcnt lgkmcnt(" #n ")" ::: "memory")
#define PG8_BAR __builtin_amdgcn_s_barrier()
#define PG8_SCHED __builtin_amdgcn_sched_barrier(0)
    Unit cur, nxt; int ui = 0;
    if (!S.next(0, cur)) return;
    f32x4 acc[2][2][4][2];
#pragma unroll
    for (int a = 0; a < 2; ++a)
#pragma unroll
        for (int b = 0; b < 2; ++b)
#pragma unroll
            for (int m = 0; m < 4; ++m)
#pragma unroll
                for (int n = 0; n < 2; ++n) acc[a][b][m][n] = (f32x4){0.f, 0.f, 0.f, 0.f};
    bf16x8 At[4][2], B0[2][2], B1[2][2];
    const char* cA = (const char*)g.A + (size_t)cur.pm * tstep; const char* cB = (const char*)g.Bt + (size_t)cur.pn * tstep;
    S.a_ready(cur);
    if constexpr (SP2) {
        PG8_STAGE(PG8_SB(0, 0), cB, voffB); PG8_STAGE(PG8_SB(0, 1), cB + hstep, voffB); PG8_STAGE(PG8_SA(0, 0), cA, voffA); PG8_STAGE(PG8_SA(0, 1), cA + hstep, voffA);
        if (wr == 1) PG8_BAR;
        PG8_WAIT_V(2); PG8_BAR;
        PG8_STAGE(PG8_SB(1, 0), cB + kstep, voffB); PG8_STAGE(PG8_SA(1, 0), cA + kstep, voffA); PG8_STAGE(PG8_SB(1, 1), cB + hstep + kstep, voffB);
        PG8_WAIT_V(6); PG8_BAR;
    } else {
        PG8_STAGE(PG8_SB(0, 0), cB, voffB); PG8_STAGE(PG8_SA(0, 0), cA, voffA); PG8_STAGE(PG8_SB(0, 1), cB + hstep, voffB); PG8_STAGE(PG8_SA(0, 1), cA + hstep, voffA);
        if (wr == 1) PG8_BAR;
        PG8_WAIT_V(4); PG8_BAR;
        PG8_STAGE(PG8_SB(1, 0), cB + kstep, voffB); PG8_STAGE(PG8_SA(1, 0), cA + kstep, voffA); PG8_STAGE(PG8_SB(1, 1), cB + hstep + kstep, voffB);
        PG8_WAIT_V(6); PG8_BAR;
    }
    for (;;) {
        const bool has_next = S.next(ui + 1, nxt);
        const char* nA = has_next ? (const char*)g.A + (size_t)nxt.pm * tstep : cA; const char* nB = has_next ? (const char*)g.Bt + (size_t)nxt.pn * tstep : cB;
        for (int t = 0; t < nt; t += 2) {
            const bool last = (t == nt - 2);
            const char* a1 = cA + (size_t)(t + 1) * kstep;
            const char* a2 = last ? nA : cA + (size_t)(t + 2) * kstep; const char* b2 = last ? nB : cB + (size_t)(t + 2) * kstep;
            const char* a3 = a2 + kstep; const char* b3 = b2 + kstep;
            if (last && has_next) S.a_ready(nxt);
            if constexpr (SP2) {
            PG8_LDB(B0, 0, 0); PG8_LDB(B1, 0, 1); PG8_SCHED; PG8_LDA(At, 0, 0); PG8_STAGE(PG8_SA(1, 1), a1 + hstep, voffA);
            PG8_WAIT_V(8); PG8_WAIT_L(0); PG8_BAR; PG8_MMA(0, 0, At, B0); PG8_MMA(0, 1, At, B1); PG8_BAR; PG8_SCHED;
            PG8_LDA(At, 0, 1); PG8_STAGE(PG8_SB(0, 0), b2, voffB); PG8_STAGE(PG8_SB(0, 1), b2 + hstep, voffB); PG8_STAGE(PG8_SA(0, 0), a2, voffA);
            PG8_WAIT_V(8); PG8_WAIT_L(0); PG8_BAR; PG8_MMA(1, 0, At, B0); PG8_MMA(1, 1, At, B1); PG8_BAR; PG8_SCHED;
            PG8_LDB(B0, 1, 0); PG8_LDB(B1, 1, 1); PG8_SCHED; PG8_LDA(At, 1, 0); PG8_STAGE(PG8_SA(0, 1), a2 + hstep, voffA);
            PG8_WAIT_V(8); PG8_WAIT_L(0); PG8_BAR; PG8_MMA(0, 0, At, B0); PG8_MMA(0, 1, At, B1); PG8_BAR; PG8_SCHED;
            PG8_LDA(At, 1, 1); PG8_STAGE(PG8_SB(1, 0), b3, voffB); PG8_STAGE(PG8_SB(1, 1), b3 + hstep, voffB); PG8_STAGE(PG8_SA(1, 0), a3, voffA);
            PG8_WAIT_V(8); PG8_WAIT_L(0); PG8_BAR; PG8_MMA(1, 0, At, B0); PG8_MMA(1, 1, At, B1); PG8_BAR; PG8_SCHED;
            } else {
            PG8_LDB(B0, 0, 0); PG8_SCHED; PG8_LDA(At, 0, 0); PG8_STAGE(PG8_SA(1, 1), a1 + hstep, voffA);
            PG8_WAIT_L(8); PG8_BAR; PG8_WAIT_L(0); PG8_MMA(0, 0, At, B0); PG8_BAR; PG8_SCHED;
            PG8_LDB(B1, 0, 1); PG8_STAGE(PG8_SB(0, 0), b2, voffB);
            PG8_BAR; PG8_WAIT_L(0); PG8_MMA(0, 1, At, B1); PG8_BAR;
            PG8_LDA(At, 0, 1); PG8_STAGE(PG8_SA(0, 0), a2, voffA);
            PG8_BAR; PG8_WAIT_L(0); PG8_MMA(1, 0, At, B0); PG8_BAR; PG8_SCHED;
            PG8_STAGE(PG8_SB(0, 1), b2 + hstep, voffB);
            PG8_WAIT_V(6); PG8_BAR; PG8_MMA(1, 1, At, B1); PG8_BAR;
            PG8_LDB(B0, 1, 0); PG8_SCHED; PG8_LDA(At, 1, 0); PG8_STAGE(PG8_SA(0, 1), a2 + hstep, voffA);
            PG8_WAIT_L(8); PG8_BAR; PG8_WAIT_L(0); PG8_MMA(0, 0, At, B0); PG8_BAR; PG8_SCHED;
            PG8_LDB(B1, 1, 1); PG8_STAGE(PG8_SB(1, 0), b3, voffB);
            PG8_BAR; PG8_WAIT_L(0); PG8_MMA(0, 1, At, B1); PG8_BAR;
            PG8_LDA(At, 1, 1); PG8_STAGE(PG8_SA(1, 0), a3, voffA);
            PG8_BAR; PG8_WAIT_L(0); PG8_MMA(1, 0, At, B0); PG8_BAR; PG8_SCHED;
            PG8_STAGE(PG8_SB(1, 1), b3 + hstep, voffB);
            PG8_WAIT_V(6); PG8_BAR; PG8_MMA(1, 1, At, B1); PG8_BAR;
            }
        }
        if constexpr (ALIGN_EPI) { if (wr == 0) PG8_BAR; }
        if constexpr (!Epi::AFTER_DRAIN) { E(acc, cur, wr, wc, fr, fq); S.done(cur); }
        if (!has_next) break;
#pragma unroll
        for (int a = 0; a < 2; ++a)
#pragma unroll
            for (int b = 0; b < 2; ++b)
#pragma unroll
                for (int m = 0; m < 4; ++m)
#pragma unroll
                    for (int n = 0; n < 2; ++n) acc[a][b][m][n] = (f32x4){0.f, 0.f, 0.f, 0.f};
        cur = nxt; cA = nA; cB = nB; ++ui;
        if constexpr (ALIGN_EPI) { if (wr == 1) PG8_BAR; }
    }
    PG8_WAIT_V(0);
    if constexpr (!ALIGN_EPI) { if (wr == 0) PG8_BAR; }
    PG8_BAR;
    if constexpr (Epi::AFTER_DRAIN) { E.fused(acc, cur, wr, wc, fr, fq, lds, wid, lane); S.done(cur); }
#undef PG8_SA
#undef PG8_SB
#undef PG8_STAGE
#undef PG8_LDA
#undef PG8_LDB
#undef PG8_MMA
#undef PG8_WAIT_V
#undef PG8_WAIT_L
#undef PG8_BAR
#undef PG8_SCHED
}
}
#ifndef PG8_SP2
#define PG8_SP2 true
#endif
#ifndef PG8_ALIGN
#define PG8_ALIGN true
#endif
#ifndef MK_MULTI
#define MK_MULTI 0
#endif

#define LAS __attribute__((address_space(3)))
typedef unsigned short bf16_t;
typedef short bf16x8 __attribute__((ext_vector_type(8)));
typedef short s16x4 __attribute__((ext_vector_type(4)));
typedef float f32x4 __attribute__((ext_vector_type(4)));
typedef float f32x16 __attribute__((ext_vector_type(16)));
typedef unsigned u32x4 __attribute__((ext_vector_type(4)));
typedef unsigned u32x2 __attribute__((ext_vector_type(2)));

constexpr int T_ = 16384, D_ = 1024, S_ = 2048, NB = 8, MT = 2048, FF = 4096, DIN = 3080;
constexpr float LOG2E = 1.4426950408889634f;
constexpr float C2Q = 0.125f * LOG2E, C2M = 0.0625f * LOG2E, EPS = 1e-6f;

constexpr size_t MiB = 1u << 20;
constexpr size_t WS_CTL = 0;
constexpr size_t WS_WA = 2 * MiB, WS_WV = 6 * MiB, WS_WOF = 8 * MiB, WS_WOC = 9 * MiB, WS_WMQ = 10 * MiB, WS_WMK = 12 * MiB, WS_WMV = 14 * MiB, WS_WMO = 16 * MiB;
constexpr size_t WS_WF1 = 18 * MiB, WS_WF2 = 26 * MiB;
constexpr size_t WS_H = 36 * MiB;
constexpr size_t WS_QK = 68 * MiB;
constexpr size_t WS_VT = 132 * MiB;
constexpr size_t WS_YF = 164 * MiB, WS_YC = 180 * MiB;
constexpr size_t WS_MEMN = 196 * MiB, WS_MEMK = 200 * MiB, WS_MEMVT = 204 * MiB;
constexpr size_t WS_LOGF = 208 * MiB, WS_C2 = 209 * MiB;
constexpr size_t WS_Y1A = 68 * MiB, WS_Y1B = 100 * MiB;
constexpr size_t WS_Q2 = 68 * MiB, WS_O2 = 100 * MiB, WS_Y2 = 132 * MiB;
constexpr size_t WS_FFH = 68 * MiB;
constexpr size_t WS_Y3 = 210 * MiB;
constexpr size_t WS_END = 242 * MiB;

constexpr int LDS_BYTES = 131072 + 1024;

struct Args {
    const float *x, *mem, *w_in, *b_fgt, *rel_bias, *g_fox_out, *g_chk_out, *w_out, *g_mix_pre, *g_mix_post, *g_mem_kv,
                *w_mq, *w_mk, *w_mv, *w_mo, *g_mem_pre, *g_mem_post, *w_ff1, *w_ff2, *g_ff_pre, *g_ff_post;
    float* out; unsigned char* ws; int ph_lo, ph_hi;
};

__device__ __forceinline__ float wave_sum(float v) {
#pragma unroll
    for (int o = 1; o < 64; o <<= 1) v += __shfl_xor(v, o);
    return v;
}
__device__ __forceinline__ unsigned pk2(float lo, float hi) { return pg8::cvt_pk_bf16(lo, hi); }
__device__ __forceinline__ float bflo(unsigned u) { return __uint_as_float(u << 16); }
__device__ __forceinline__ float bfhi(unsigned u) { return __uint_as_float(u & 0xffff0000u); }

__device__ __forceinline__ void p0_prep(const Args& a, LAS unsigned char* lds, int tid, int lane, int wid, int gw, int NGW) {
    unsigned char* ws = a.ws;
    LAS float* wf = (LAS float*)(lds + 73728);
    for (int i = tid; i < 8192; i += 512) { const int k = i >> 3, j = i & 7; wf[i] = a.w_in[(size_t)k * DIN + 1536 + j]; }
    __syncthreads();
    LAS float* scr = (LAS float*)(lds + wid * 8448);
    for (int it = gw; it < 8192; it += NGW) {
        int r = it; const float* W; int ldw, scol, nb, ldt, drow0 = 0; bf16_t* WT; float cs = 1.f; const float* ks = nullptr;
        if (r < 1536) { const int j = r >> 8; r &= 255; W = a.w_in; ldw = DIN; nb = 16; ldt = 1024;
            scol = j == 0 ? 0 : j == 1 ? 512 : j == 2 ? 1544 : j == 3 ? 2056 : j == 4 ? 1024 : 2568;
            WT = (bf16_t*)(ws + (j < 4 ? WS_WA : WS_WV)); drow0 = j < 4 ? j * 512 : (j - 4) * 512; cs = (j == 0 || j == 2) ? C2Q : 1.f; }
        else if (r < 2048) { r -= 1536; const int j = r >> 8; r &= 255; W = a.w_out + (size_t)j * 512 * 1024; ldw = 1024; scol = 0; nb = 32; ldt = 512;
            WT = (bf16_t*)(ws + (j ? WS_WOC : WS_WOF)); ks = j ? a.g_chk_out : a.g_fox_out; }
        else if (r < 4096) { r -= 2048; const int j = r >> 9; r &= 511; W = j == 0 ? a.w_mq : j == 1 ? a.w_mk : j == 2 ? a.w_mv : a.w_mo; ldw = 1024; scol = 0; nb = 32; ldt = 1024;
            WT = (bf16_t*)(ws + WS_WMQ + (size_t)j * 2 * MiB); cs = j == 0 ? C2M : 1.f; }
        else if (r < 6144) { r -= 4096; W = a.w_ff1; ldw = 4096; scol = 0; nb = 128; ldt = 1024; WT = (bf16_t*)(ws + WS_WF1); }
        else { r -= 6144; W = a.w_ff2; ldw = 1024; scol = 0; nb = 32; ldt = 4096; WT = (bf16_t*)(ws + WS_WF2); }
        const int kb = r / nb, nbi = r % nb, k0 = 64 * kb, n0 = 32 * nbi;
#pragma unroll 8
        for (int i = 0; i < 32; ++i) { const int kk = 2 * i + (lane >> 5); float v = W[(size_t)(k0 + kk) * ldw + scol + n0 + (lane & 31)];
            if (ks) v *= ks[k0 + kk]; scr[kk * 33 + (lane & 31)] = v * cs; }
        asm volatile("s_waitcnt lgkmcnt(0)" ::: "memory");
        const int c = lane & 7;
#pragma unroll
        for (int j = 0; j < 4; ++j) { const int n = (lane >> 3) + 8 * j; const LAS float* s = scr + (8 * c) * 33 + n;
            u32x4 o; o.x = pk2(s[0 * 33], s[1 * 33]); o.y = pk2(s[2 * 33], s[3 * 33]); o.z = pk2(s[4 * 33], s[5 * 33]); o.w = pk2(s[6 * 33], s[7 * 33]);
            *(u32x4*)(WT + (size_t)(drow0 + n0 + n) * ldt + k0 + 8 * c) = o; }
        asm volatile("s_waitcnt lgkmcnt(0)" ::: "memory");
    }
    {
        f32x4 gv[4];
#pragma unroll
        for (int j = 0; j < 4; ++j) gv[j] = ((const f32x4*)a.g_mix_pre)[lane + 64 * j];
        bf16_t* H = (bf16_t*)(ws + WS_H); float* logf = (float*)(ws + WS_LOGF);
        for (int m = gw; m < T_; m += NGW) {
            const f32x4* xr = (const f32x4*)(a.x + (size_t)m * D_) + lane;
            f32x4 v[4]; float ss = 0.f;
#pragma unroll
            for (int j = 0; j < 4; ++j) { v[j] = xr[64 * j]; ss += (v[j].x * v[j].x + v[j].y * v[j].y) + (v[j].z * v[j].z + v[j].w * v[j].w); }
            const float r = rsqrtf(wave_sum(ss) * (1.f / D_) + EPS);
            u32x2* o8 = (u32x2*)(H + (size_t)m * D_) + lane;
            float d0 = 0.f, d1 = 0.f, d2 = 0.f, d3 = 0.f, d4 = 0.f, d5 = 0.f, d6 = 0.f, d7 = 0.f;
#pragma unroll
            for (int j = 0; j < 4; ++j) { v[j] = v[j] * r * gv[j]; u32x2 w; w.x = pk2(v[j].x, v[j].y); w.y = pk2(v[j].z, v[j].w); o8[64 * j] = w;
#pragma unroll
                for (int e = 0; e < 4; ++e) { const int k = 4 * lane + 256 * j + e; const f32x4 w0 = *(const LAS f32x4*)(wf + k * 8), w1 = *(const LAS f32x4*)(wf + k * 8 + 4); const float hv = v[j][e];
                    d0 += hv * w0.x; d1 += hv * w0.y; d2 += hv * w0.z; d3 += hv * w0.w; d4 += hv * w1.x; d5 += hv * w1.y; d6 += hv * w1.z; d7 += hv * w1.w; } }
            d0 = wave_sum(d0); d1 = wave_sum(d1); d2 = wave_sum(d2); d3 = wave_sum(d3); d4 = wave_sum(d4); d5 = wave_sum(d5); d6 = wave_sum(d6); d7 = wave_sum(d7);
            if (lane < 8) { float z = lane == 0 ? d0 : lane == 1 ? d1 : lane == 2 ? d2 : lane == 3 ? d3 : lane == 4 ? d4 : lane == 5 ? d5 : lane == 6 ? d6 : d7;
                z += a.b_fgt[lane]; const float lf = z >= 0.f ? -log1pf(expf(-z)) : z - log1pf(expf(z)); logf[(size_t)m * 8 + lane] = lf; }
        }
    }
    {
        bf16_t* MN = (bf16_t*)(ws + WS_MEMN);
        for (int m = gw; m < MT; m += NGW) {
            const f32x4* xr = (const f32x4*)(a.mem + (size_t)m * D_) + lane;
            f32x4 v[4]; float ss = 0.f;
#pragma unroll
            for (int j = 0; j < 4; ++j) { v[j] = xr[64 * j]; ss += (v[j].x * v[j].x + v[j].y * v[j].y) + (v[j].z * v[j].z + v[j].w * v[j].w); }
            const float r = rsqrtf(wave_sum(ss) * (1.f / D_) + EPS);
            u32x2* o8 = (u32x2*)(MN + (size_t)m * D_) + lane;
#pragma unroll
            for (int j = 0; j < 4; ++j) { const f32x4 g = ((const f32x4*)a.g_mem_kv)[lane + 64 * j]; const f32x4 h = v[j] * r * g; u32x2 w; w.x = pk2(h.x, h.y); w.y = pk2(h.z, h.w); o8[64 * j] = w; }
        }
    }
}

__device__ __forceinline__ void cumsum_bh(const Args& a, LAS unsigned char* lds, int bh, int tid, int lane, int wid) {
    const float* logf = (const float*)(a.ws + WS_LOGF); float* c2 = (float*)(a.ws + WS_C2);
    const int b = bh >> 3, h = bh & 7;
    float v0 = logf[((size_t)b * S_ + 4 * tid + 0) * 8 + h], v1 = logf[((size_t)b * S_ + 4 * tid + 1) * 8 + h], v2 = logf[((size_t)b * S_ + 4 * tid + 2) * 8 + h], v3 = logf[((size_t)b * S_ + 4 * tid + 3) * 8 + h];
    v1 += v0; v2 += v1; v3 += v2;
    float incl = v3;
#pragma unroll
    for (int o = 1; o < 64; o <<= 1) { const float t = __shfl_up(incl, o); if (lane >= o) incl += t; }
    LAS float* wt = (LAS float*)(lds);
    __syncthreads();
    if (lane == 63) wt[wid] = incl;
    __syncthreads();
    float pre = incl - v3;
#pragma unroll
    for (int w = 0; w < 8; ++w) if (w < wid) pre += wt[w];
    f32x4 o; o.x = (pre + v0) * LOG2E; o.y = (pre + v1) * LOG2E; o.z = (pre + v2) * LOG2E; o.w = (pre + v3) * LOG2E;
    *(f32x4*)(c2 + (size_t)bh * S_ + 4 * tid) = o;
    __syncthreads();
}

constexpr int KP = 144, VP = 136;
constexpr int A_K0 = 0, A_V0 = 2 * 64 * KP, A_NC = A_V0 + 2 * 64 * VP, A_TB = A_NC + 8192;
__device__ __forceinline__ int crow(int r, int hi) { return (r & 3) + 8 * (r >> 2) + 4 * hi; }

template <int MODE  >
__device__ __forceinline__ void attn_unit(const Args& a, LAS unsigned char* lds, int b, int h, int qb, int tid, int lane, int wid) {
    const bf16_t* QK = (const bf16_t*)(a.ws + WS_QK); const bf16_t* VT = (const bf16_t*)(a.ws + WS_VT);
    bf16_t* Y = (bf16_t*)(a.ws + (MODE == 0 ? WS_YF : WS_YC));
    const int r32 = lane & 31, hi = lane >> 5;
    const int qcol = MODE == 0 ? 0 : 1024, kcol = qcol + 512, vrow0 = MODE == 0 ? 0 : 512;
    const size_t tok0 = (size_t)b * S_;
    const int q = qb * 256 + wid * 32 + r32;
    LAS float* nc = (LAS float*)(lds + A_NC); LAS float* tb = (LAS float*)(lds + A_TB);
    float cq = 0.f;
    if (MODE == 0) {
        const float* c2 = (const float*)(a.ws + WS_C2) + (size_t)(b * 8 + h) * S_;
        for (int i = tid; i < (qb + 1) * 256; i += 512) nc[i] = -c2[i];
        cq = c2[q];
    } else {
        const float* rb = a.rel_bias + (size_t)h * 257; const float base = rb[256];
        if (tid < 257) tb[tid] = (rb[tid] - base) * LOG2E;
    }
    bf16x8 qf[4];
    { const bf16_t* qp = QK + (tok0 + q) * 2048 + qcol + h * 64 + hi * 8;
#pragma unroll
      for (int d0 = 0; d0 < 4; ++d0) qf[d0] = *(const bf16x8*)(qp + d0 * 16); }
    const int t_lo = MODE == 0 ? 0 : (4 * qb - 8 > 0 ? 4 * qb - 8 : 0), t_hi = 4 * qb + 3;
    const int kr = tid >> 3, kc = tid & 7;
    const bf16_t* ksrc = QK + (tok0 + kr) * 2048 + kcol + h * 64 + kc * 8;
    const bf16_t* vsrc = VT + (size_t)(vrow0 + h * 64 + kr) * T_ + tok0 + kc * 8;
    const int kdst = A_K0 + kr * KP + kc * 16, vdst = A_V0 + kr * VP + kc * 16;
    u32x4 kreg = *(const u32x4*)(ksrc + (size_t)t_lo * 64 * 2048), vreg = *(const u32x4*)(vsrc + (size_t)t_lo * 64);
    *(LAS u32x4*)(lds + kdst) = kreg; *(LAS u32x2*)(lds + vdst) = (u32x2){vreg.x, vreg.y}; *(LAS u32x2*)(lds + vdst + 8) = (u32x2){vreg.z, vreg.w};
    __syncthreads();
    float m = -INFINITY, l = 0.f; f32x16 o0 = {}, o1 = {};
    const int q0w = qb * 256 + wid * 32, cw = 4 * qb + (wid >> 1);
    for (int t = t_lo; t <= t_hi; ++t) {
        const int cur = (t - t_lo) & 1;
        if (t < t_hi) { kreg = *(const u32x4*)(ksrc + (size_t)(t + 1) * 64 * 2048); vreg = *(const u32x4*)(vsrc + (size_t)(t + 1) * 64); }
        bool part;
        if (MODE == 0) part = (64 * t <= q0w + 31); else part = (t <= cw && t >= cw - 8);
        if (part) {
            const LAS unsigned char* Kb = lds + A_K0 + cur * 64 * KP; const LAS unsigned char* Vb = lds + A_V0 + cur * 64 * VP;
            f32x16 s0, s1;
#pragma unroll
            for (int r = 0; r < 16; ++r) { s0[r] = cq; s1[r] = cq; }
#pragma unroll
            for (int d0 = 0; d0 < 4; ++d0) {
                const bf16x8 k0f = *(const LAS bf16x8*)(Kb + r32 * KP + d0 * 32 + hi * 16), k1f = *(const LAS bf16x8*)(Kb + (r32 + 32) * KP + d0 * 32 + hi * 16);
                s0 = __builtin_amdgcn_mfma_f32_32x32x16_bf16(k0f, qf[d0], s0, 0, 0, 0); s1 = __builtin_amdgcn_mfma_f32_32x32x16_bf16(k1f, qf[d0], s1, 0, 0, 0);
            }
            if (MODE == 0) {
#pragma unroll
                for (int g = 0; g < 4; ++g) { const f32x4 n0 = *(const LAS f32x4*)(nc + 64 * t + 8 * g + 4 * hi), n1 = *(const LAS f32x4*)(nc + 64 * t + 32 + 8 * g + 4 * hi);
#pragma unroll
                    for (int e = 0; e < 4; ++e) { s0[4 * g + e] += n0[e]; s1[4 * g + e] += n1[e]; } }
                if (64 * t + 63 > q0w) {
#pragma unroll
                    for (int r = 0; r < 16; ++r) { const int kv = 64 * t + crow(r, hi); if (kv > q) s0[r] = -INFINITY; if (kv + 32 > q) s1[r] = -INFINITY; }
                }
            } else {
                if (t >= cw - 2) {
#pragma unroll
                    for (int r = 0; r < 16; ++r) { const int rel = q - (64 * t + crow(r, hi)); int i0 = rel < 128 ? rel : 128; int i1 = rel - 32 < 128 ? rel - 32 : 128;
                        s0[r] += tb[i0 + 128]; s1[r] += tb[i1 + 128]; }
                }
            }
            float mx = fmaxf(s0[0], s1[0]);
#pragma unroll
            for (int r = 1; r < 16; ++r) mx = fmaxf(mx, fmaxf(s0[r], s1[r]));
            mx = fmaxf(mx, __shfl_xor(mx, 32));
            const float mn = fmaxf(m, mx), alpha = __builtin_amdgcn_exp2f(m - mn); m = mn;
            float ps = 0.f;
#pragma unroll
            for (int r = 0; r < 16; ++r) { s0[r] = __builtin_amdgcn_exp2f(s0[r] - mn); s1[r] = __builtin_amdgcn_exp2f(s1[r] - mn); ps += s0[r] + s1[r]; }
            l = l * alpha + ps;
#pragma unroll
            for (int r = 0; r < 16; ++r) { o0[r] *= alpha; o1[r] *= alpha; }
            bf16x8 pa[2][2];
            { u32x4 w;
              w.x = pk2(s0[0], s0[1]); w.y = pk2(s0[2], s0[3]); w.z = pk2(s0[4], s0[5]); w.w = pk2(s0[6], s0[7]); pa[0][0] = __builtin_bit_cast(bf16x8, w);
              w.x = pk2(s0[8], s0[9]); w.y = pk2(s0[10], s0[11]); w.z = pk2(s0[12], s0[13]); w.w = pk2(s0[14], s0[15]); pa[0][1] = __builtin_bit_cast(bf16x8, w);
              w.x = pk2(s1[0], s1[1]); w.y = pk2(s1[2], s1[3]); w.z = pk2(s1[4], s1[5]); w.w = pk2(s1[6], s1[7]); pa[1][0] = __builtin_bit_cast(bf16x8, w);
              w.x = pk2(s1[8], s1[9]); w.y = pk2(s1[10], s1[11]); w.z = pk2(s1[12], s1[13]); w.w = pk2(s1[14], s1[15]); pa[1][1] = __builtin_bit_cast(bf16x8, w); }
#pragma unroll
            for (int sub = 0; sub < 2; ++sub)
#pragma unroll
                for (int hf = 0; hf < 2; ++hf) {
                    const int kb2 = (32 * sub + 16 * hf + 4 * hi) * 2;
                    const u32x2 a0 = *(const LAS u32x2*)(Vb + r32 * VP + kb2), a1 = *(const LAS u32x2*)(Vb + r32 * VP + kb2 + 16);
                    const u32x2 b0 = *(const LAS u32x2*)(Vb + (r32 + 32) * VP + kb2), b1 = *(const LAS u32x2*)(Vb + (r32 + 32) * VP + kb2 + 16);
                    const bf16x8 va = __builtin_bit_cast(bf16x8, (u32x4){a0.x, a0.y, a1.x, a1.y}), vb = __builtin_bit_cast(bf16x8, (u32x4){b0.x, b0.y, b1.x, b1.y});
                    o0 = __builtin_amdgcn_mfma_f32_32x32x16_bf16(va, pa[sub][hf], o0, 0, 0, 0); o1 = __builtin_amdgcn_mfma_f32_32x32x16_bf16(vb, pa[sub][hf], o1, 0, 0, 0);
                }
        }
        if (t < t_hi) { const int nb = (cur ^ 1);
            *(LAS u32x4*)(lds + kdst + nb * 64 * KP) = kreg; *(LAS u32x2*)(lds + vdst + nb * 64 * VP) = (u32x2){vreg.x, vreg.y}; *(LAS u32x2*)(lds + vdst + nb * 64 * VP + 8) = (u32x2){vreg.z, vreg.w}; }
        __syncthreads();
    }
    l += __shfl_xor(l, 32);
    const float inv = 1.f / l;
    bf16_t* yp = Y + (tok0 + q) * 512 + h * 64 + 4 * hi;
#pragma unroll
    for (int g = 0; g < 4; ++g) {
        u32x2 w; w.x = pk2(o0[4 * g] * inv, o0[4 * g + 1] * inv); w.y = pk2(o0[4 * g + 2] * inv, o0[4 * g + 3] * inv); *(u32x2*)(yp + 8 * g) = w;
        w.x = pk2(o1[4 * g] * inv, o1[4 * g + 1] * inv); w.y = pk2(o1[4 * g + 2] * inv, o1[4 * g + 3] * inv); *(u32x2*)(yp + 32 + 8 * g) = w;
    }
}

constexpr int XVP = 520;
__device__ __forceinline__ void xattn_unit(const Args& a, LAS unsigned char* lds, int b, int hd, int qb, int tid, int lane, int wid) {
    const bf16_t* Q2 = (const bf16_t*)(a.ws + WS_Q2); const bf16_t* MK = (const bf16_t*)(a.ws + WS_MEMK); const bf16_t* MVT = (const bf16_t*)(a.ws + WS_MEMVT);
    bf16_t* O2 = (bf16_t*)(a.ws + WS_O2);
    const int r32 = lane & 31, hi = lane >> 5;
    const size_t tok = (size_t)b * S_ + qb * 256 + wid * 32 + r32;
    f32x16 s[8];
#pragma unroll
    for (int j = 0; j < 8; ++j) s[j] = (f32x16){};
    for (int dc = 0; dc < 4; ++dc) {
        __syncthreads();
#pragma unroll
        for (int i = 0; i < 4; ++i) { const int idx = tid + 512 * i, row = idx >> 3, ch = idx & 7;
            const u32x4 v = *(const u32x4*)(MK + (size_t)(b * 256 + row) * 1024 + hd * 256 + dc * 64 + ch * 8); *(LAS u32x4*)(lds + row * KP + ch * 16) = v; }
        bf16x8 qf[4];
#pragma unroll
        for (int d0 = 0; d0 < 4; ++d0) qf[d0] = *(const bf16x8*)(Q2 + tok * 1024 + hd * 256 + dc * 64 + d0 * 16 + hi * 8);
        __syncthreads();
#pragma unroll
        for (int d0 = 0; d0 < 4; ++d0)
#pragma unroll
            for (int j = 0; j < 8; ++j) { const bf16x8 kf = *(const LAS bf16x8*)(lds + (32 * j + r32) * KP + d0 * 32 + hi * 16); s[j] = __builtin_amdgcn_mfma_f32_32x32x16_bf16(kf, qf[d0], s[j], 0, 0, 0); }
    }
    float mx = s[0][0];
#pragma unroll
    for (int j = 0; j < 8; ++j)
#pragma unroll
        for (int r = 0; r < 16; ++r) mx = fmaxf(mx, s[j][r]);
    mx = fmaxf(mx, __shfl_xor(mx, 32));
    float l = 0.f;
    bf16x8 pa[8][2];
#pragma unroll
    for (int j = 0; j < 8; ++j) {
#pragma unroll
        for (int r = 0; r < 16; ++r) { s[j][r] = __builtin_amdgcn_exp2f(s[j][r] - mx); l += s[j][r]; }
        u32x4 w;
        w.x = pk2(s[j][0], s[j][1]); w.y = pk2(s[j][2], s[j][3]); w.z = pk2(s[j][4], s[j][5]); w.w = pk2(s[j][6], s[j][7]); pa[j][0] = __builtin_bit_cast(bf16x8, w);
        w.x = pk2(s[j][8], s[j][9]); w.y = pk2(s[j][10], s[j][11]); w.z = pk2(s[j][12], s[j][13]); w.w = pk2(s[j][14], s[j][15]); pa[j][1] = __builtin_bit_cast(bf16x8, w);
    }
    l += __shfl_xor(l, 32);
    const float inv = 1.f / l;
    for (int ds = 0; ds < 8; ++ds) {
        __syncthreads();
#pragma unroll
        for (int i = 0; i < 2; ++i) { const int idx = tid + 512 * i, row = idx >> 5, ch = idx & 31;
            const u32x4 v = *(const u32x4*)(MVT + (size_t)(hd * 256 + ds * 32 + row) * MT + b * 256 + ch * 8);
            *(LAS u32x2*)(lds + row * XVP + ch * 16) = (u32x2){v.x, v.y}; *(LAS u32x2*)(lds + row * XVP + ch * 16 + 8) = (u32x2){v.z, v.w}; }
        __syncthreads();
        f32x16 o = {};
#pragma unroll
        for (int j = 0; j < 8; ++j)
#pragma unroll
            for (int hf = 0; hf < 2; ++hf) { const int kb2 = (32 * j + 16 * hf + 4 * hi) * 2;
                const u32x2 a0 = *(const LAS u32x2*)(lds + r32 * XVP + kb2), a1 = *(const LAS u32x2*)(lds + r32 * XVP + kb2 + 16);
                const bf16x8 va = __builtin_bit_cast(bf16x8, (u32x4){a0.x, a0.y, a1.x, a1.y});
                o = __builtin_amdgcn_mfma_f32_32x32x16_bf16(va, pa[j][hf], o, 0, 0, 0); }
        bf16_t* op = O2 + tok * 1024 + hd * 256 + ds * 32 + 4 * hi;
#pragma unroll
        for (int g = 0; g < 4; ++g) { u32x2 w; w.x = pk2(o[4 * g] * inv, o[4 * g + 1] * inv); w.y = pk2(o[4 * g + 2] * inv, o[4 * g + 3] * inv); *(u32x2*)(op + 8 * g) = w; }
    }
    __syncthreads();
}

template <bool TWO, bool NEXT>
__device__ __forceinline__ void row_pass(const Args& a, const float* xin, const bf16_t* ya, const bf16_t* yb, const float* g_post, const float* g_pre, int lane, int gw, int NGW) {
    const bf16_t* YF = (const bf16_t*)(a.ws + WS_YF); const bf16_t* YC = (const bf16_t*)(a.ws + WS_YC); bf16_t* H = (bf16_t*)(a.ws + WS_H);
    f32x4 gp[4], gn[4];
#pragma unroll
    for (int j = 0; j < 4; ++j) { gp[j] = ((const f32x4*)g_post)[lane + 64 * j]; if (NEXT) gn[j] = ((const f32x4*)g_pre)[lane + 64 * j]; }
    for (int m = gw; m < T_; m += NGW) {
        float rf = 1.f, rc = 1.f;
        if (TWO) {
            const u32x4 f = *((const u32x4*)(YF + (size_t)m * 512) + lane), c = *((const u32x4*)(YC + (size_t)m * 512) + lane);
            float sf = 0.f, sc = 0.f;
#pragma unroll
            for (int e = 0; e < 4; ++e) { const float f0 = bflo(f[e]), f1 = bfhi(f[e]), c0 = bflo(c[e]), c1 = bfhi(c[e]); sf += f0 * f0 + f1 * f1; sc += c0 * c0 + c1 * c1; }
            rf = rsqrtf(wave_sum(sf) * (1.f / 512.f) + EPS); rc = rsqrtf(wave_sum(sc) * (1.f / 512.f) + EPS);
        }
        f32x4 y[4]; float ss = 0.f;
#pragma unroll
        for (int j = 0; j < 4; ++j) {
            const u32x2 p = *((const u32x2*)(ya + (size_t)m * D_) + lane + 64 * j);
            y[j] = (f32x4){bflo(p.x), bfhi(p.x), bflo(p.y), bfhi(p.y)};
            if (TWO) { const u32x2 p2 = *((const u32x2*)(yb + (size_t)m * D_) + lane + 64 * j); y[j] = y[j] * rf + (f32x4){bflo(p2.x), bfhi(p2.x), bflo(p2.y), bfhi(p2.y)} * rc; }
            ss += (y[j].x * y[j].x + y[j].y * y[j].y) + (y[j].z * y[j].z + y[j].w * y[j].w);
        }
        const float r = rsqrtf(wave_sum(ss) * (1.f / D_) + EPS);
        const f32x4* xr = (const f32x4*)(xin + (size_t)m * D_) + lane; f32x4* xo = (f32x4*)(a.out + (size_t)m * D_) + lane;
        float s2 = 0.f;
#pragma unroll
        for (int j = 0; j < 4; ++j) { y[j] = xr[64 * j] + y[j] * r * gp[j]; xo[64 * j] = y[j]; s2 += (y[j].x * y[j].x + y[j].y * y[j].y) + (y[j].z * y[j].z + y[j].w * y[j].w); }
        if (NEXT) {
            const float r2 = rsqrtf(wave_sum(s2) * (1.f / D_) + EPS);
            u32x2* o8 = (u32x2*)(H + (size_t)m * D_) + lane;
#pragma unroll
            for (int j = 0; j < 4; ++j) { const f32x4 h = y[j] * r2 * gn[j]; u32x2 w; w.x = pk2(h.x, h.y); w.y = pk2(h.z, h.w); o8[64 * j] = w; }
        }
    }
}

template <int ACT>
__device__ __forceinline__ void run_gemm(LAS unsigned char* lds, const bf16_t* A, const bf16_t* Bt, int M, int N, int K, bf16_t* O, int ldc, int G, int c) {
    pg8::Gemm g{A, Bt, M, N, K}; pg8::StaticOrder S; S.init(M, N, G, c);
    pg8::EpiStore<ACT> E{O, ldc};
    pg8::gemm_phase<pg8::EpiStore<ACT>, pg8::StaticOrder, PG8_ALIGN, PG8_SP2>(lds, g, S, E);
    __syncthreads();
}

__global__ void __launch_bounds__(512) fwd_kernel(Args a) {
    extern __shared__ __attribute__((aligned(16))) unsigned char lds_raw[];
    LAS unsigned char* lds = (LAS unsigned char*)lds_raw;
    const int tid = threadIdx.x, lane = tid & 63, wid = __builtin_amdgcn_readfirstlane(tid >> 6);
    const int G = gridDim.x, bx = blockIdx.x;
    const int gw = bx * 8 + wid, NGW = G * 8;
    unsigned char* ws = a.ws;
    const int lo = a.ph_lo, hi = a.ph_hi;
#define IN(k) (lo <= (k) && (k) < hi)
#define SEAM(k) do { if (IN(k) && IN((k) + 1)) cg::this_grid().sync(); } while (0)
    bf16_t* H = (bf16_t*)(ws + WS_H);

    if (IN(0)) { p0_prep(a, lds, tid, lane, wid, gw, NGW); }
    SEAM(0);
    if (IN(1)) {
        if (bx >= 64 && bx < 128) cumsum_bh(a, lds, bx - 64, tid, lane, wid);
        run_gemm<0>(lds, H, (const bf16_t*)(ws + WS_WA), T_, 2048, 1024, (bf16_t*)(ws + WS_QK), 2048, G, bx);
        run_gemm<0>(lds, (const bf16_t*)(ws + WS_WV), H, 1024, T_, 1024, (bf16_t*)(ws + WS_VT), T_, G, bx);
        run_gemm<0>(lds, (const bf16_t*)(ws + WS_MEMN), (const bf16_t*)(ws + WS_WMK), MT, 1024, 1024, (bf16_t*)(ws + WS_MEMK), 1024, G, bx);
        run_gemm<0>(lds, (const bf16_t*)(ws + WS_WMV), (const bf16_t*)(ws + WS_MEMN), 1024, MT, 1024, (bf16_t*)(ws + WS_MEMVT), MT, G, (bx + G - 32) % G);
    }
    SEAM(1);
    if (IN(2)) {
        unsigned* ctr = (unsigned*)(ws + WS_CTL);
        LAS int* uq = (LAS int*)(lds + 131072);
        for (;;) {
            if (tid == 0) *uq = (int)atomicAdd(ctr, 1u);
            __syncthreads();
            const int u = *uq;
            __syncthreads();
            if (u >= 1024) break;
            int mode, qb, bh;
            if (u < 320) { mode = 0; qb = 7 - (u >> 6); bh = u & 63; }
            else if (u < 704) { const int j = u - 320; mode = 1; qb = 2 + (j >> 6); bh = j & 63; }
            else if (u < 768) { mode = 0; qb = 2; bh = u & 63; }
            else if (u < 832) { mode = 0; qb = 1; bh = u & 63; }
            else if (u < 896) { mode = 1; qb = 1; bh = u & 63; }
            else if (u < 960) { mode = 0; qb = 0; bh = u & 63; }
            else { mode = 1; qb = 0; bh = u & 63; }
            if (mode == 0) attn_unit<0>(a, lds, bh >> 3, bh & 7, qb, tid, lane, wid);
            else attn_unit<1>(a, lds, bh >> 3, bh & 7, qb, tid, lane, wid);
        }
    }
    SEAM(2);
    if (IN(3)) {
        run_gemm<0>(lds, (const bf16_t*)(ws + WS_YF), (const bf16_t*)(ws + WS_WOF), T_, 1024, 512, (bf16_t*)(ws + WS_Y1A), 1024, G, bx);
        run_gemm<0>(lds, (const bf16_t*)(ws + WS_YC), (const bf16_t*)(ws + WS_WOC), T_, 1024, 512, (bf16_t*)(ws + WS_Y1B), 1024, G, bx);
    }
    SEAM(3);
    if (IN(4)) row_pass<true, true>(a, a.x, (const bf16_t*)(ws + WS_Y1A), (const bf16_t*)(ws + WS_Y1B), a.g_mix_post, a.g_mem_pre, lane, gw, NGW);
    SEAM(4);
    if (IN(5)) run_gemm<0>(lds, H, (const bf16_t*)(ws + WS_WMQ), T_, 1024, 1024, (bf16_t*)(ws + WS_Q2), 1024, G, bx);
    SEAM(5);
    if (IN(6)) { for (int u = bx; u < 256; u += G) xattn_unit(a, lds, u >> 5, (u >> 3) & 3, u & 7, tid, lane, wid); }
    SEAM(6);
    if (IN(7)) run_gemm<0>(lds, (const bf16_t*)(ws + WS_O2), (const bf16_t*)(ws + WS_WMO), T_, 1024, 1024, (bf16_t*)(ws + WS_Y2), 1024, G, bx);
    SEAM(7);
    if (IN(8)) row_pass<false, true>(a, a.out, (const bf16_t*)(ws + WS_Y2), nullptr, a.g_mem_post, a.g_ff_pre, lane, gw, NGW);
    SEAM(8);
    if (IN(9)) run_gemm<2>(lds, H, (const bf16_t*)(ws + WS_WF1), T_, FF, 1024, (bf16_t*)(ws + WS_FFH), FF, G, bx);
    SEAM(9);
    if (IN(10)) run_gemm<0>(lds, (const bf16_t*)(ws + WS_FFH), (const bf16_t*)(ws + WS_WF2), T_, 1024, FF, (bf16_t*)(ws + WS_Y3), 1024, G, bx);
    SEAM(10);
    if (IN(11)) row_pass<false, false>(a, a.out, (const bf16_t*)(ws + WS_Y3), nullptr, a.g_ff_post, nullptr, lane, gw, NGW);
#undef IN
#undef SEAM
}

constexpr int N_PHASES = 12;

extern "C" void kernel_launch(void* const* d_in, const int* in_sizes, int n_in, void* d_out, int out_size, void* d_ws, size_t ws_size, hipStream_t stream) {
    static int grid = 0;
    if (grid == 0) {
        if (n_in != 21 || out_size != T_ * D_ || ws_size < WS_END) { fprintf(stderr, "kernel_launch: unexpected shapes (n_in %d out %d ws %zu)\n", n_in, out_size, ws_size); grid = -1; return; }
        int dev = 0, cus = 0, per_cu = 0;
        hipGetDevice(&dev); hipDeviceGetAttribute(&cus, hipDeviceAttributeMultiprocessorCount, dev);
        if (hipFuncSetAttribute((const void*)fwd_kernel, hipFuncAttributeMaxDynamicSharedMemorySize, LDS_BYTES) != hipSuccess) { fprintf(stderr, "kernel_launch: hipFuncSetAttribute failed\n"); grid = -1; return; }
        if (hipOccupancyMaxActiveBlocksPerMultiprocessor(&per_cu, (const void*)fwd_kernel, 512, LDS_BYTES) != hipSuccess || per_cu < 1) { fprintf(stderr, "kernel_launch: occupancy query says %d\n", per_cu); per_cu = 1; }
        (void)hipGetLastError();
        grid = cus * 1;
        if (grid <= 0) grid = 256;
    }
    if (grid < 0) return;
    hipMemsetAsync((char*)d_ws + WS_CTL, 0, 4096, stream);
    Args a{};
    const float** p = (const float**)&a;
    for (int i = 0; i < 21; ++i) p[i] = (const float*)d_in[i];
    a.out = (float*)d_out; a.ws = (unsigned char*)d_ws;
#if MK_MULTI
    for (int ph = 0; ph < N_PHASES; ++ph) { a.ph_lo = ph; a.ph_hi = ph + 1; hipLaunchKernelGGL(fwd_kernel, dim3(grid), dim3(512), LDS_BYTES, stream, a); }
#else
    a.ph_lo = 0; a.ph_hi = N_PHASES;
    void* args[] = {&a};
    hipError_t e = hipLaunchCooperativeKernel((const void*)fwd_kernel, dim3(grid), dim3(512), args, LDS_BYTES, stream);
    if (e != hipSuccess) fprintf(stderr, "cooperative launch failed: %s (grid %d)\n", hipGetErrorString(e), grid);
#endif
}
```

```cpp
#include <hip/hip_runtime.h>
#include <hip/hip_cooperative_groups.h>
#include <cstdio>
#include <cstdint>
namespace cg = cooperative_groups;
namespace pg8 {
#define PG8_LAS __attribute__((address_space(3)))
typedef unsigned short bf16_t;
typedef short bf16x8 __attribute__((ext_vector_type(8)));
typedef float f32x4 __attribute__((ext_vector_type(4)));
typedef unsigned u32x4 __attribute__((ext_vector_type(4)));
constexpr int BM = 256, BK = 64, HALF = 128, HTB = HALF * BK * 2  , STAGE_BYTES = 8 * HTB, NXCD = 8, WGM = 8;

__host__ __device__ __forceinline__ int lds_byte(int r, int c) { const int st = (r >> 4) * 2 + (c >> 5), rr = r & 15, cc = c & 31, ob = rr * 64 + cc * 2; return st * 1024 + (ob ^ (((ob >> 9) & 1) << 5)); }
__host__ __device__ __forceinline__ void stage_rc(int b, int& R, int& C) { const int st = b / 1024, sb = b % 1024, swz = sb ^ (((sb >> 9) & 1) << 5); R = (st >> 1) * 16 + swz / 64; C = (st & 1) * 32 + (swz % 64) / 2; }
__host__ __device__ __forceinline__ int perm32(int rho) { const int n = rho >> 4, i = rho & 15; return 8 * (i >> 2) + 4 * n + (i & 3); }

struct Unit { int pm, pn; };
struct Gemm { const bf16_t* A; const bf16_t* Bt; int M, N, K; };

struct StaticOrder {
    int nM, nN, nwg, G, c;
    __host__ __device__ void init(int M, int N, int G_, int c_) { nM = M / BM; nN = N / BM; nwg = nM * nN; G = G_; c = c_; }
    __host__ __device__ bool next(int i, Unit& u) const {
        const long L = (long)i * G + c; if (L >= nwg) return false;
        int wgid = (int)L; { const int q = nwg / NXCD, r = nwg % NXCD, xcd = wgid % NXCD, off = wgid / NXCD; wgid = (xcd < r ? xcd * (q + 1) : r * (q + 1) + (xcd - r) * q) + off; }
        const int nig = WGM * nN, gid = wgid / nig, fm = gid * WGM, gsz = (nM - fm) < WGM ? (nM - fm) : WGM;
        u.pm = fm + ((wgid % nig) % gsz); u.pn = (wgid % nig) / gsz; return true;
    }
    __device__ __forceinline__ void a_ready(const Unit&) const {}
    __device__ __forceinline__ void done(const Unit&) const {}
};

__device__ __forceinline__ unsigned cvt_pk_bf16(float lo, float hi) { unsigned r; asm volatile("v_cvt_pk_bf16_f32 %0, %1, %2" : "=v"(r) : "v"(lo), "v"(hi)); return r; }
typedef float f32x2 __attribute__((ext_vector_type(2)));
struct OneUnit { Unit u;
    __device__ __forceinline__ bool next(int i, Unit& o) const { if (i != 0) return false; o = u; return true; }
    __device__ __forceinline__ void a_ready(const Unit&) const {}
    __device__ __forceinline__ void done(const Unit&) const {} };
template <int ACT  > struct EpiStore {
    static constexpr bool PERM = true, AFTER_DRAIN = false;
    bf16_t* O; int ldc;
    __device__ __forceinline__ void operator()(const f32x4 (&acc)[2][2][4][2], const Unit& u, int wr, int wc, int fr, int fq) const {
        const int row0 = u.pm * BM + wr * 64 + fr; const int col0 = u.pn * BM + wc * 32 + 8 * fq;
#pragma unroll
        for (int ai = 0; ai < 2; ++ai)
#pragma unroll
            for (int m = 0; m < 4; ++m) { bf16_t* rowp = O + (size_t)(row0 + ai * HALF + m * 16) * ldc + col0;
#pragma unroll
                for (int bj = 0; bj < 2; ++bj) { f32x4 v0 = acc[ai][bj][m][0], v1 = acc[ai][bj][m][1];
                    if (ACT == 2) {
#pragma unroll
                        for (int e = 0; e < 4; ++e) { float a = v0[e] > 0.f ? v0[e] : 0.f; v0[e] = a * a; float b = v1[e] > 0.f ? v1[e] : 0.f; v1[e] = b * b; } }
                    u32x4 w; w.x = cvt_pk_bf16(v0[0], v0[1]); w.y = cvt_pk_bf16(v0[2], v0[3]); w.z = cvt_pk_bf16(v1[0], v1[1]); w.w = cvt_pk_bf16(v1[2], v1[3]);
                    *(u32x4*)(rowp + bj * HALF) = w; } }
    }
};
template <class Epi, class Sched, bool ALIGN_EPI = false, bool SP2 = false>
__device__ __forceinline__ void gemm_phase(PG8_LAS unsigned char* lds, const Gemm g, const Sched& S, const Epi& E) {
    const int tid = threadIdx.x, wid = __builtin_amdgcn_readfirstlane(tid >> 6), lane = tid & 63, wr = wid >> 2, wc = wid & 3, fr = lane & 15, fq = lane >> 4;
    const int K = g.K, nt = K / BK;
    unsigned voffA[2], voffB[2];
#pragma unroll
    for (int i = 0; i < 2; ++i) { int R, C; stage_rc(tid * 16 + i * 8192, R, C); const int Rb = Epi::PERM ? ((R & ~31) + perm32(R & 31)) : R;
        voffA[i] = (unsigned)(R * K + C) * 2u; voffB[i] = (unsigned)(Rb * K + C) * 2u; }
    const size_t kstep = (size_t)(BK * 2);
    const size_t hstep = (size_t)HALF * K * 2;
    const size_t tstep = 2 * hstep;
    const unsigned ldsw = (unsigned)wid * 1024u;
    const int aoff = lds_byte(wr * 64 + fr, fq * 8), boff = lds_byte(wc * 32 + fr, fq * 8);
#define PG8_SA(b, h) (((b) * 2 + (h)) * HTB)
#define PG8_SB(b, h) ((4 + (b) * 2 + (h)) * HTB)
#define PG8_STAGE(bufoff, gbase, voff) do { _Pragma("unroll") for (int _i = 0; _i < 2; ++_i) \
        __builtin_amdgcn_global_load_lds((const unsigned*)((const char*)(gbase) + (voff)[_i]), (PG8_LAS unsigned*)(lds + (bufoff) + ldsw + _i * 8192), 16, 0, 0); } while (0)
#define PG8_LDA(dst, b, h) do { _Pragma("unroll") for (int m = 0; m < 4; ++m) _Pragma("unroll") for (int k = 0; k < 2; ++k) dst[m][k] = *(const PG8_LAS bf16x8*)(lds + PG8_SA(b, h) + aoff + m * 2048 + k * 1024); } while (0)
#define PG8_LDB(dst, b, h) do { _Pragma("unroll") for (int n = 0; n < 2; ++n) _Pragma("unroll") for (int k = 0; k < 2; ++k) dst[n][k] = *(const PG8_LAS bf16x8*)(lds + PG8_SB(b, h) + boff + n * 2048 + k * 1024); } while (0)
#define PG8_MMA(ai, bj, At, Bt) do { __builtin_amdgcn_s_setprio(1); _Pragma("unroll") for (int m = 0; m < 4; ++m) _Pragma("unroll") for (int n = 0; n < 2; ++n) _Pragma("unroll") for (int k = 0; k < 2; ++k) \
        acc[ai][bj][m][n] = __builtin_amdgcn_mfma_f32_16x16x32_bf16(Bt[n][k], At[m][k], acc[ai][bj][m][n], 0, 0, 0); __builtin_amdgcn_s_setprio(0); } while (0)
#define PG8_WAIT_V(n) asm volatile("s_waitcnt vmcnt(" #n ")" ::: "memory")
#define PG8_WAIT_L(n) asm volatile("s_waitcnt lgkmcnt(" #n ")" ::: "memory")
#define PG8_BAR __builtin_amdgcn_s_barrier()
#define PG8_SCHED __builtin_amdgcn_sched_barrier(0)
    Unit cur, nxt; int ui = 0;
    if (!S.next(0, cur)) return;
    f32x4 acc[2][2][4][2];
#pragma unroll
    for (int a = 0; a < 2; ++a)
#pragma unroll
        for (int b = 0; b < 2; ++b)
#pragma unroll
            for (int m = 0; m < 4; ++m)
#pragma unroll
                for (int n = 0; n < 2; ++n) acc[a][b][m][n] = (f32x4){0.f, 0.f, 0.f, 0.f};
    bf16x8 At[4][2], B0[2][2], B1[2][2];
    const char* cA = (const char*)g.A + (size_t)cur.pm * tstep; const char* cB = (const char*)g.Bt + (size_t)cur.pn * tstep;
    S.a_ready(cur);
    if constexpr (SP2) {
        PG8_STAGE(PG8_SB(0, 0), cB, voffB); PG8_STAGE(PG8_SB(0, 1), cB + hstep, voffB); PG8_STAGE(PG8_SA(0, 0), cA, voffA); PG8_STAGE(PG8_SA(0, 1), cA + hstep, voffA);
        if (wr == 1) PG8_BAR;
        PG8_WAIT_V(2); PG8_BAR;
        PG8_STAGE(PG8_SB(1, 0), cB + kstep, voffB); PG8_STAGE(PG8_SA(1, 0), cA + kstep, voffA); PG8_STAGE(PG8_SB(1, 1), cB + hstep + kstep, voffB);
        PG8_WAIT_V(6); PG8_BAR;
    } else {
        PG8_STAGE(PG8_SB(0, 0), cB, voffB); PG8_STAGE(PG8_SA(0, 0), cA, voffA); PG8_STAGE(PG8_SB(0, 1), cB + hstep, voffB); PG8_STAGE(PG8_SA(0, 1), cA + hstep, voffA);
        if (wr == 1) PG8_BAR;
        PG8_WAIT_V(4); PG8_BAR;
        PG8_STAGE(PG8_SB(1, 0), cB + kstep, voffB); PG8_STAGE(PG8_SA(1, 0), cA + kstep, voffA); PG8_STAGE(PG8_SB(1, 1), cB + hstep + kstep, voffB);
        PG8_WAIT_V(6); PG8_BAR;
    }
    for (;;) {
        const bool has_next = S.next(ui + 1, nxt);
        const char* nA = has_next ? (const char*)g.A + (size_t)nxt.pm * tstep : cA; const char* nB = has_next ? (const char*)g.Bt + (size_t)nxt.pn * tstep : cB;
        for (int t = 0; t < nt; t += 2) {
            const bool last = (t == nt - 2);
            const char* a1 = cA + (size_t)(t + 1) * kstep;
            const char* a2 = last ? nA : cA + (size_t)(t + 2) * kstep; const char* b2 = last ? nB : cB + (size_t)(t + 2) * kstep;
            const char* a3 = a2 + kstep; const char* b3 = b2 + kstep;
            if (last && has_next) S.a_ready(nxt);
            if constexpr (SP2) {
            PG8_LDB(B0, 0, 0); PG8_LDB(B1, 0, 1); PG8_SCHED; PG8_LDA(At, 0, 0); PG8_STAGE(PG8_SA(1, 1), a1 + hstep, voffA);
            PG8_WAIT_V(8); PG8_WAIT_L(0); PG8_BAR; PG8_MMA(0, 0, At, B0); PG8_MMA(0, 1, At, B1); PG8_BAR; PG8_SCHED;
            PG8_LDA(At, 0, 1); PG8_STAGE(PG8_SB(0, 0), b2, voffB); PG8_STAGE(PG8_SB(0, 1), b2 + hstep, voffB); PG8_STAGE(PG8_SA(0, 0), a2, voffA);
            PG8_WAIT_V(8); PG8_WAIT_L(0); PG8_BAR; PG8_MMA(1, 0, At, B0); PG8_MMA(1, 1, At, B1); PG8_BAR; PG8_SCHED;
            PG8_LDB(B0, 1, 0); PG8_LDB(B1, 1, 1); PG8_SCHED; PG8_LDA(At, 1, 0); PG8_STAGE(PG8_SA(0, 1), a2 + hstep, voffA);
            PG8_WAIT_V(8); PG8_WAIT_L(0); PG8_BAR; PG8_MMA(0, 0, At, B0); PG8_MMA(0, 1, At, B1); PG8_BAR; PG8_SCHED;
            PG8_LDA(At, 1, 1); PG8_STAGE(PG8_SB(1, 0), b3, voffB); PG8_STAGE(PG8_SB(1, 1), b3 + hstep, voffB); PG8_STAGE(PG8_SA(1, 0), a3, voffA);
            PG8_WAIT_V(8); PG8_WAIT_L(0); PG8_BAR; PG8_MMA(1, 0, At, B0); PG8_MMA(1, 1, At, B1); PG8_BAR; PG8_SCHED;
            } else {
            PG8_LDB(B0, 0, 0); PG8_SCHED; PG8_LDA(At, 0, 0); PG8_STAGE(PG8_SA(1, 1), a1 + hstep, voffA);
            PG8_WAIT_L(8); PG8_BAR; PG8_WAIT_L(0); PG8_MMA(0, 0, At, B0); PG8_BAR; PG8_SCHED;
            PG8_LDB(B1, 0, 1); PG8_STAGE(PG8_SB(0, 0), b2, voffB);
            PG8_BAR; PG8_WAIT_L(0); PG8_MMA(0, 1, At, B1); PG8_BAR;
            PG8_LDA(At, 0, 1); PG8_STAGE(PG8_SA(0, 0), a2, voffA);
            PG8_BAR; PG8_WAIT_L(0); PG8_MMA(1, 0, At, B0); PG8_BAR; PG8_SCHED;
            PG8_STAGE(PG8_SB(0, 1), b2 + hstep, voffB);
            PG8_WAIT_V(6); PG8_BAR; PG8_MMA(1, 1, At, B1); PG8_BAR;
            PG8_LDB(B0, 1, 0); PG8_SCHED; PG8_LDA(At, 1, 0); PG8_STAGE(PG8_SA(0, 1), a2 + hstep, voffA);
            PG8_WAIT_L(8); PG8_BAR; PG8_WAIT_L(0); PG8_MMA(0, 0, At, B0); PG8_BAR; PG8_SCHED;
            PG8_LDB(B1, 1, 1); PG8_STAGE(PG8_SB(1, 0), b3, voffB);
            PG8_BAR; PG8_WAIT_L(0); PG8_MMA(0, 1, At, B1); PG8_BAR;
            PG8_LDA(At, 1, 1); PG8_STAGE(PG8_SA(1, 0), a3, voffA);
            PG8_BAR; PG8_WAIT_L(0); PG8_MMA(1, 0, At, B0); PG8_BAR; PG8_SCHED;
            PG8_STAGE(PG8_SB(1, 1), b3 + hstep, voffB);
            PG8_WAIT_V(6); PG8_BAR; PG8_MMA(1, 1, At, B1); PG8_BAR;
            }
        }
        if constexpr (ALIGN_EPI) { if (wr == 0) PG8_BAR; }
        if constexpr (!Epi::AFTER_DRAIN) { E(acc, cur, wr, wc, fr, fq); S.done(cur); }
        if (!has_next) break;
#pragma unroll
        for (int a = 0; a < 2; ++a)
#pragma unroll
            for (int b = 0; b < 2; ++b)
#pragma unroll
                for (int m = 0; m < 4; ++m)
#pragma unroll
                    for (int n = 0; n < 2; ++n) acc[a][b][m][n] = (f32x4){0.f, 0.f, 0.f, 0.f};
        cur = nxt; cA = nA; cB = nB; ++ui;
        if constexpr (ALIGN_EPI) { if (wr == 1) PG8_BAR; }
    }
    PG8_WAIT_V(0);
    if constexpr (!ALIGN_EPI) { if (wr == 0) PG8_BAR; }
    PG8_BAR;
    if constexpr (Epi::AFTER_DRAIN) { E.fused(acc, cur, wr, wc, fr, fq, lds, wid, lane); S.done(cur); }
#undef PG8_SA
#undef PG8_SB
#undef PG8_STAGE
#undef PG8_LDA
#undef PG8_LDB
#undef PG8_MMA
#undef PG8_WAIT_V
#undef PG8_WAIT_L
#undef PG8_BAR
#undef PG8_SCHED
}
}
#ifndef PG8_SP2
#define PG8_SP2 true
#endif
#ifndef PG8_ALIGN
#define PG8_ALIGN true
#endif
#ifndef MK_MULTI
#define MK_MULTI 0
#endif

#ifndef REP_MASK
#define REP_MASK 0
#endif
#ifndef REP_N
#define REP_N 1
#endif
#define LAS __attribute__((address_space(3)))
typedef unsigned short bf16_t;
typedef short bf16x8 __attribute__((ext_vector_type(8)));
typedef short s16x4 __attribute__((ext_vector_type(4)));
typedef float f32x4 __attribute__((ext_vector_type(4)));
typedef float f32x16 __attribute__((ext_vector_type(16)));
typedef unsigned u32x4 __attribute__((ext_vector_type(4)));
typedef unsigned u32x2 __attribute__((ext_vector_type(2)));

constexpr int T_ = 16384, D_ = 1024, S_ = 2048, NB = 8, MT = 2048, FF = 4096, DIN = 3080;
constexpr float LOG2E = 1.4426950408889634f;
constexpr float C2Q = 0.125f * LOG2E, C2M = 0.0625f * LOG2E, EPS = 1e-6f;

constexpr size_t MiB = 1u << 20;
constexpr size_t WS_CTL = 0;
constexpr size_t WS_WA = 2 * MiB, WS_WV = 6 * MiB, WS_WOF = 8 * MiB, WS_WOC = 9 * MiB, WS_WMQ = 10 * MiB, WS_WMK = 12 * MiB, WS_WMV = 14 * MiB, WS_WMO = 16 * MiB;
constexpr size_t WS_WF1 = 18 * MiB, WS_WF2 = 26 * MiB;
constexpr size_t WS_H = 36 * MiB;
constexpr size_t WS_QK = 68 * MiB;
constexpr size_t WS_VT = 132 * MiB;
constexpr size_t WS_YF = 164 * MiB, WS_YC = 180 * MiB;
constexpr size_t WS_MEMN = 196 * MiB, WS_MEMK = 200 * MiB, WS_MEMVT = 204 * MiB;
constexpr size_t WS_LOGF = 208 * MiB, WS_C2 = 209 * MiB;
constexpr size_t WS_Y1A = 68 * MiB, WS_Y1B = 100 * MiB;
constexpr size_t WS_Q2 = 68 * MiB, WS_O2 = 100 * MiB, WS_Y2 = 132 * MiB;
constexpr size_t WS_FFH = 68 * MiB;
constexpr size_t WS_Y3 = 210 * MiB;
constexpr size_t WS_END = 242 * MiB;

constexpr int LDS_BYTES = 131072 + 1024;

struct Args {
    const float *x, *mem, *w_in, *b_fgt, *rel_bias, *g_fox_out, *g_chk_out, *w_out, *g_mix_pre, *g_mix_post, *g_mem_kv,
                *w_mq, *w_mk, *w_mv, *w_mo, *g_mem_pre, *g_mem_post, *w_ff1, *w_ff2, *g_ff_pre, *g_ff_post;
    float* out; unsigned char* ws; int ph_lo, ph_hi;
};

__device__ __forceinline__ float wave_sum(float v) {
#pragma unroll
    for (int o = 1; o < 64; o <<= 1) v += __shfl_xor(v, o);
    return v;
}
__device__ __forceinline__ unsigned pk2(float lo, float hi) { return pg8::cvt_pk_bf16(lo, hi); }
__device__ __forceinline__ float bflo(unsigned u) { return __uint_as_float(u << 16); }
__device__ __forceinline__ float bfhi(unsigned u) { return __uint_as_float(u & 0xffff0000u); }

__device__ __forceinline__ void p0_prep(const Args& a, LAS unsigned char* lds, int tid, int lane, int wid, int gw, int NGW) {
    unsigned char* ws = a.ws;
    LAS float* wf = (LAS float*)(lds + 73728);
    for (int i = tid; i < 8192; i += 512) { const int k = i >> 3, j = i & 7; wf[i] = a.w_in[(size_t)k * DIN + 1536 + j]; }
    __syncthreads();
    LAS float* scr = (LAS float*)(lds + wid * 8448);
    for (int it = gw; it < 8192; it += NGW) {
        int r = it; const float* W; int ldw, scol, nb, ldt, drow0 = 0; bf16_t* WT; float cs = 1.f; const float* ks = nullptr;
        if (r < 1536) { const int j = r >> 8; r &= 255; W = a.w_in; ldw = DIN; nb = 16; ldt = 1024;
            scol = j == 0 ? 0 : j == 1 ? 512 : j == 2 ? 1544 : j == 3 ? 2056 : j == 4 ? 1024 : 2568;
            WT = (bf16_t*)(ws + (j < 4 ? WS_WA : WS_WV)); drow0 = j < 4 ? j * 512 : (j - 4) * 512; cs = (j == 0 || j == 2) ? C2Q : 1.f; }
        else if (r < 2048) { r -= 1536; const int j = r >> 8; r &= 255; W = a.w_out + (size_t)j * 512 * 1024; ldw = 1024; scol = 0; nb = 32; ldt = 512;
            WT = (bf16_t*)(ws + (j ? WS_WOC : WS_WOF)); ks = j ? a.g_chk_out : a.g_fox_out; }
        else if (r < 4096) { r -= 2048; const int j = r >> 9; r &= 511; W = j == 0 ? a.w_mq : j == 1 ? a.w_mk : j == 2 ? a.w_mv : a.w_mo; ldw = 1024; scol = 0; nb = 32; ldt = 1024;
            WT = (bf16_t*)(ws + WS_WMQ + (size_t)j * 2 * MiB); cs = j == 0 ? C2M : 1.f; }
        else if (r < 6144) { r -= 4096; W = a.w_ff1; ldw = 4096; scol = 0; nb = 128; ldt = 1024; WT = (bf16_t*)(ws + WS_WF1); }
        else { r -= 6144; W = a.w_ff2; ldw = 1024; scol = 0; nb = 32; ldt = 4096; WT = (bf16_t*)(ws + WS_WF2); }
        const int kb = r / nb, nbi = r % nb, k0 = 64 * kb, n0 = 32 * nbi;
        { f32x4 tv[8]; const int c4 = (lane & 7) * 4;
#pragma unroll
          for (int i = 0; i < 8; ++i) { const int kk = 8 * i + (lane >> 3); tv[i] = *(const f32x4*)(W + (size_t)(k0 + kk) * ldw + scol + n0 + c4); }
#pragma unroll
          for (int i = 0; i < 8; ++i) { const int kk = 8 * i + (lane >> 3); const float sc = ks ? ks[k0 + kk] * cs : cs; LAS float* d = scr + kk * 33 + c4;
              d[0] = tv[i].x * sc; d[1] = tv[i].y * sc; d[2] = tv[i].z * sc; d[3] = tv[i].w * sc; } }
        asm volatile("s_waitcnt lgkmcnt(0)" ::: "memory");
        const int c = lane & 7;
#pragma unroll
        for (int j = 0; j < 4; ++j) { const int n = (lane >> 3) + 8 * j; const LAS float* s = scr + (8 * c) * 33 + n;
            u32x4 o; o.x = pk2(s[0 * 33], s[1 * 33]); o.y = pk2(s[2 * 33], s[3 * 33]); o.z = pk2(s[4 * 33], s[5 * 33]); o.w = pk2(s[6 * 33], s[7 * 33]);
            *(u32x4*)(WT + (size_t)(drow0 + n0 + n) * ldt + k0 + 8 * c) = o; }
        asm volatile("s_waitcnt lgkmcnt(0)" ::: "memory");
    }
    {
        f32x4 gv[4];
#pragma unroll
        for (int j = 0; j < 4; ++j) gv[j] = ((const f32x4*)a.g_mix_pre)[lane + 64 * j];
        bf16_t* H = (bf16_t*)(ws + WS_H); float* logf = (float*)(ws + WS_LOGF);
        f32x4 vn[4];
        if (gw < T_) { const f32x4* xr = (const f32x4*)(a.x + (size_t)gw * D_) + lane;
#pragma unroll
            for (int j = 0; j < 4; ++j) vn[j] = xr[64 * j]; }
        for (int m = gw; m < T_; m += NGW) {
            f32x4 v[4]; float ss = 0.f;
#pragma unroll
            for (int j = 0; j < 4; ++j) v[j] = vn[j];
            if (m + NGW < T_) { const f32x4* xr = (const f32x4*)(a.x + (size_t)(m + NGW) * D_) + lane;
#pragma unroll
                for (int j = 0; j < 4; ++j) vn[j] = xr[64 * j]; }
#pragma unroll
            for (int j = 0; j < 4; ++j) ss += (v[j].x * v[j].x + v[j].y * v[j].y) + (v[j].z * v[j].z + v[j].w * v[j].w);
            const float r = rsqrtf(wave_sum(ss) * (1.f / D_) + EPS);
            u32x2* o8 = (u32x2*)(H + (size_t)m * D_) + lane;
            float d0 = 0.f, d1 = 0.f, d2 = 0.f, d3 = 0.f, d4 = 0.f, d5 = 0.f, d6 = 0.f, d7 = 0.f;
#pragma unroll
            for (int j = 0; j < 4; ++j) { v[j] = v[j] * r * gv[j]; u32x2 w; w.x = pk2(v[j].x, v[j].y); w.y = pk2(v[j].z, v[j].w); o8[64 * j] = w;
#pragma unroll
                for (int e = 0; e < 4; ++e) { const int k = 4 * lane + 256 * j + e; const f32x4 w0 = *(const LAS f32x4*)(wf + k * 8), w1 = *(const LAS f32x4*)(wf + k * 8 + 4); const float hv = v[j][e];
                    d0 += hv * w0.x; d1 += hv * w0.y; d2 += hv * w0.z; d3 += hv * w0.w; d4 += hv * w1.x; d5 += hv * w1.y; d6 += hv * w1.z; d7 += hv * w1.w; } }
            d0 = wave_sum(d0); d1 = wave_sum(d1); d2 = wave_sum(d2); d3 = wave_sum(d3); d4 = wave_sum(d4); d5 = wave_sum(d5); d6 = wave_sum(d6); d7 = wave_sum(d7);
            if (lane < 8) { float z = lane == 0 ? d0 : lane == 1 ? d1 : lane == 2 ? d2 : lane == 3 ? d3 : lane == 4 ? d4 : lane == 5 ? d5 : lane == 6 ? d6 : d7;
                z += a.b_fgt[lane]; const float lf = z >= 0.f ? -log1pf(expf(-z)) : z - log1pf(expf(z)); logf[(size_t)m * 8 + lane] = lf; }
        }
    }
    {
        bf16_t* MN = (bf16_t*)(ws + WS_MEMN);
        for (int m = gw; m < MT; m += NGW) {
            const f32x4* xr = (const f32x4*)(a.mem + (size_t)m * D_) + lane;
            f32x4 v[4]; float ss = 0.f;
#pragma unroll
            for (int j = 0; j < 4; ++j) { v[j] = xr[64 * j]; ss += (v[j].x * v[j].x + v[j].y * v[j].y) + (v[j].z * v[j].z + v[j].w * v[j].w); }
            const float r = rsqrtf(wave_sum(ss) * (1.f / D_) + EPS);
            u32x2* o8 = (u32x2*)(MN + (size_t)m * D_) + lane;
#pragma unroll
            for (int j = 0; j < 4; ++j) { const f32x4 g = ((const f32x4*)a.g_mem_kv)[lane + 64 * j]; const f32x4 h = v[j] * r * g; u32x2 w; w.x = pk2(h.x, h.y); w.y = pk2(h.z, h.w); o8[64 * j] = w; }
        }
    }
}

__device__ __forceinline__ void cumsum_bh(const Args& a, LAS unsigned char* lds, int bh, int tid, int lane, int wid) {
    const float* logf = (const float*)(a.ws + WS_LOGF); float* c2 = (float*)(a.ws + WS_C2);
    const int b = bh >> 3, h = bh & 7;
    float v0 = logf[((size_t)b * S_ + 4 * tid + 0) * 8 + h], v1 = logf[((size_t)b * S_ + 4 * tid + 1) * 8 + h], v2 = logf[((size_t)b * S_ + 4 * tid + 2) * 8 + h], v3 = logf[((size_t)b * S_ + 4 * tid + 3) * 8 + h];
    v1 += v0; v2 += v1; v3 += v2;
    float incl = v3;
#pragma unroll
    for (int o = 1; o < 64; o <<= 1) { const float t = __shfl_up(incl, o); if (lane >= o) incl += t; }
    LAS float* wt = (LAS float*)(lds);
    __syncthreads();
    if (lane == 63) wt[wid] = incl;
    __syncthreads();
    float pre = incl - v3;
#pragma unroll
    for (int w = 0; w < 8; ++w) if (w < wid) pre += wt[w];
    f32x4 o; o.x = (pre + v0) * LOG2E; o.y = (pre + v1) * LOG2E; o.z = (pre + v2) * LOG2E; o.w = (pre + v3) * LOG2E;
    *(f32x4*)(c2 + (size_t)bh * S_ + 4 * tid) = o;
    __syncthreads();
}

constexpr int KP = 144, VP = 136;
constexpr int A_K0 = 0, A_V0 = 2 * 64 * KP, A_NC = A_V0 + 2 * 64 * VP, A_TB = A_NC + 8192;
__device__ __forceinline__ int crow(int r, int hi) { return (r & 3) + 8 * (r >> 2) + 4 * hi; }

template <int MODE  >
__device__ __forceinline__ void attn_unit(const Args& a, LAS unsigned char* lds, int b, int h, int qb, int tid, int lane, int wid) {
    const bf16_t* QK = (const bf16_t*)(a.ws + WS_QK); const bf16_t* VT = (const bf16_t*)(a.ws + WS_VT);
    bf16_t* Y = (bf16_t*)(a.ws + (MODE == 0 ? WS_YF : WS_YC));
    const int r32 = lane & 31, hi = lane >> 5;
    const int qcol = MODE == 0 ? 0 : 1024, kcol = qcol + 512, vrow0 = MODE == 0 ? 0 : 512;
    const size_t tok0 = (size_t)b * S_;
    const int q = qb * 256 + wid * 32 + r32;
    LAS float* nc = (LAS float*)(lds + A_NC); LAS float* tb = (LAS float*)(lds + A_TB);
    float cq = 0.f;
    if (MODE == 0) {
        const float* c2 = (const float*)(a.ws + WS_C2) + (size_t)(b * 8 + h) * S_;
        for (int i = tid; i < (qb + 1) * 256; i += 512) nc[i] = -c2[i];
        cq = c2[q];
    } else {
        const float* rb = a.rel_bias + (size_t)h * 257; const float base = rb[256];
        if (tid < 257) tb[tid] = (rb[tid] - base) * LOG2E;
    }
    bf16x8 qf[4];
    { const bf16_t* qp = QK + (tok0 + q) * 2048 + qcol + h * 64 + hi * 8;
#pragma unroll
      for (int d0 = 0; d0 < 4; ++d0) qf[d0] = *(const bf16x8*)(qp + d0 * 16); }
    const int t_lo = MODE == 0 ? 0 : (4 * qb - 8 > 0 ? 4 * qb - 8 : 0), t_hi = 4 * qb + 3;
    const int kr = tid >> 3, kc = tid & 7;
    const bf16_t* ksrc = QK + (tok0 + kr) * 2048 + kcol + h * 64 + kc * 8;
    const bf16_t* vsrc = VT + (size_t)(vrow0 + h * 64 + kr) * T_ + tok0 + kc * 8;
    const int kdst = A_K0 + kr * KP + kc * 16, vdst = A_V0 + kr * VP + kc * 16;
    u32x4 kreg = *(const u32x4*)(ksrc + (size_t)t_lo * 64 * 2048), vreg = *(const u32x4*)(vsrc + (size_t)t_lo * 64);
    *(LAS u32x4*)(lds + kdst) = kreg; *(LAS u32x2*)(lds + vdst) = (u32x2){vreg.x, vreg.y}; *(LAS u32x2*)(lds + vdst + 8) = (u32x2){vreg.z, vreg.w};
    __syncthreads();
    float m = -INFINITY, l = 0.f; f32x16 o0 = {}, o1 = {};
    const int q0w = qb * 256 + wid * 32, cw = 4 * qb + (wid >> 1);
    for (int t = t_lo; t <= t_hi; ++t) {
        const int cur = (t - t_lo) & 1;
        if (t < t_hi) { kreg = *(const u32x4*)(ksrc + (size_t)(t + 1) * 64 * 2048); vreg = *(const u32x4*)(vsrc + (size_t)(t + 1) * 64); }
        bool part;
        if (MODE == 0) part = (64 * t <= q0w + 31); else part = (t <= cw && t >= cw - 8);
        if (part) {
            const LAS unsigned char* Kb = lds + A_K0 + cur * 64 * KP; const LAS unsigned char* Vb = lds + A_V0 + cur * 64 * VP;
            f32x16 s0, s1;
#pragma unroll
            for (int r = 0; r < 16; ++r) { s0[r] = cq; s1[r] = cq; }
#pragma unroll
            for (int d0 = 0; d0 < 4; ++d0) {
                const bf16x8 k0f = *(const LAS bf16x8*)(Kb + r32 * KP + d0 * 32 + hi * 16), k1f = *(const LAS bf16x8*)(Kb + (r32 + 32) * KP + d0 * 32 + hi * 16);
                s0 = __builtin_amdgcn_mfma_f32_32x32x16_bf16(k0f, qf[d0], s0, 0, 0, 0); s1 = __builtin_amdgcn_mfma_f32_32x32x16_bf16(k1f, qf[d0], s1, 0, 0, 0);
            }
            if (MODE == 0) {
#pragma unroll
                for (int g = 0; g < 4; ++g) { const f32x4 n0 = *(const LAS f32x4*)(nc + 64 * t + 8 * g + 4 * hi), n1 = *(const LAS f32x4*)(nc + 64 * t + 32 + 8 * g + 4 * hi);
#pragma unroll
                    for (int e = 0; e < 4; ++e) { s0[4 * g + e] += n0[e]; s1[4 * g + e] += n1[e]; } }
                if (64 * t + 63 > q0w) {
#pragma unroll
                    for (int r = 0; r < 16; ++r) { const int kv = 64 * t + crow(r, hi); if (kv > q) s0[r] = -INFINITY; if (kv + 32 > q) s1[r] = -INFINITY; }
                }
            } else {
                if (t >= cw - 2) {
#pragma unroll
                    for (int r = 0; r < 16; ++r) { const int rel = q - (64 * t + crow(r, hi)); int i0 = rel < 128 ? rel : 128; int i1 = rel - 32 < 128 ? rel - 32 : 128;
                        s0[r] += tb[i0 + 128]; s1[r] += tb[i1 + 128]; }
                }
            }
            float mx = fmaxf(s0[0], s1[0]);
#pragma unroll
            for (int r = 1; r < 16; ++r) mx = fmaxf(mx, fmaxf(s0[r], s1[r]));
            mx = fmaxf(mx, __shfl_xor(mx, 32));
            const float mn = fmaxf(m, mx), alpha = __builtin_amdgcn_exp2f(m - mn); m = mn;
            float ps = 0.f;
#pragma unroll
            for (int r = 0; r < 16; ++r) { s0[r] = __builtin_amdgcn_exp2f(s0[r] - mn); s1[r] = __builtin_amdgcn_exp2f(s1[r] - mn); ps += s0[r] + s1[r]; }
            l = l * alpha + ps;
#pragma unroll
            for (int r = 0; r < 16; ++r) { o0[r] *= alpha; o1[r] *= alpha; }
            bf16x8 pa[2][2];
            { u32x4 w;
              w.x = pk2(s0[0], s0[1]); w.y = pk2(s0[2], s0[3]); w.z = pk2(s0[4], s0[5]); w.w = pk2(s0[6], s0[7]); pa[0][0] = __builtin_bit_cast(bf16x8, w);
              w.x = pk2(s0[8], s0[9]); w.y = pk2(s0[10], s0[11]); w.z = pk2(s0[12], s0[13]); w.w = pk2(s0[14], s0[15]); pa[0][1] = __builtin_bit_cast(bf16x8, w);
              w.x = pk2(s1[0], s1[1]); w.y = pk2(s1[2], s1[3]); w.z = pk2(s1[4], s1[5]); w.w = pk2(s1[6], s1[7]); pa[1][0] = __builtin_bit_cast(bf16x8, w);
              w.x = pk2(s1[8], s1[9]); w.y = pk2(s1[10], s1[11]); w.z = pk2(s1[12], s1[13]); w.w = pk2(s1[14], s1[15]); pa[1][1] = __builtin_bit_cast(bf16x8, w); }
#pragma unroll
            for (int sub = 0; sub < 2; ++sub)
#pragma unroll
                for (int hf = 0; hf < 2; ++hf) {
                    const int kb2 = (32 * sub + 16 * hf + 4 * hi) * 2;
                    const u32x2 a0 = *(const LAS u32x2*)(Vb + r32 * VP + kb2), a1 = *(const LAS u32x2*)(Vb + r32 * VP + kb2 + 16);
                    const u32x2 b0 = *(const LAS u32x2*)(Vb + (r32 + 32) * VP + kb2), b1 = *(const LAS u32x2*)(Vb + (r32 + 32) * VP + kb2 + 16);
                    const bf16x8 va = __builtin_bit_cast(bf16x8, (u32x4){a0.x, a0.y, a1.x, a1.y}), vb = __builtin_bit_cast(bf16x8, (u32x4){b0.x, b0.y, b1.x, b1.y});
                    o0 = __builtin_amdgcn_mfma_f32_32x32x16_bf16(va, pa[sub][hf], o0, 0, 0, 0); o1 = __builtin_amdgcn_mfma_f32_32x32x16_bf16(vb, pa[sub][hf], o1, 0, 0, 0);
                }
        }
        if (t < t_hi) { const int nb = (cur ^ 1);
            *(LAS u32x4*)(lds + kdst + nb * 64 * KP) = kreg; *(LAS u32x2*)(lds + vdst + nb * 64 * VP) = (u32x2){vreg.x, vreg.y}; *(LAS u32x2*)(lds + vdst + nb * 64 * VP + 8) = (u32x2){vreg.z, vreg.w}; }
        __syncthreads();
    }
    l += __shfl_xor(l, 32);
    const float inv = 1.f / l;
    bf16_t* yp = Y + (tok0 + q) * 512 + h * 64 + 4 * hi;
#pragma unroll
    for (int g = 0; g < 4; ++g) {
        u32x2 w; w.x = pk2(o0[4 * g] * inv, o0[4 * g + 1] * inv); w.y = pk2(o0[4 * g + 2] * inv, o0[4 * g + 3] * inv); *(u32x2*)(yp + 8 * g) = w;
        w.x = pk2(o1[4 * g] * inv, o1[4 * g + 1] * inv); w.y = pk2(o1[4 * g + 2] * inv, o1[4 * g + 3] * inv); *(u32x2*)(yp + 32 + 8 * g) = w;
    }
}

constexpr int XVP = 520;
constexpr int XK_BYTES = 256 * KP, XV_BYTES = 32 * XVP, XV_OFF = 2 * XK_BYTES;
__device__ __forceinline__ void xattn_unit(const Args& a, LAS unsigned char* lds, int b, int hd, int qb, int tid, int lane, int wid) {
    const bf16_t* Q2 = (const bf16_t*)(a.ws + WS_Q2); const bf16_t* MK = (const bf16_t*)(a.ws + WS_MEMK); const bf16_t* MVT = (const bf16_t*)(a.ws + WS_MEMVT);
    bf16_t* O2 = (bf16_t*)(a.ws + WS_O2);
    const int r32 = lane & 31, hi = lane >> 5;
    const size_t tok = (size_t)b * S_ + qb * 256 + wid * 32 + r32;
    const bf16_t* ksrc = MK + (size_t)(b * 256 + (tid >> 3)) * 1024 + hd * 256 + (tid & 7) * 8;
    const int kdst = (tid >> 3) * KP + (tid & 7) * 16;
    const bf16_t* vsrc = MVT + (size_t)(hd * 256 + (tid >> 5)) * MT + b * 256 + (tid & 31) * 8;
    const int vdst = XV_OFF + (tid >> 5) * XVP + (tid & 31) * 16;
    u32x4 kr[4], vr[2];
#pragma unroll
    for (int i = 0; i < 4; ++i) kr[i] = *(const u32x4*)(ksrc + (size_t)i * 64 * 1024);
#pragma unroll
    for (int i = 0; i < 4; ++i) *(LAS u32x4*)(lds + kdst + i * 64 * KP) = kr[i];
    __syncthreads();
    f32x16 s[8];
#pragma unroll
    for (int j = 0; j < 8; ++j) s[j] = (f32x16){};
#pragma unroll
    for (int dc = 0; dc < 4; ++dc) {
        if (dc < 3) {
#pragma unroll
            for (int i = 0; i < 4; ++i) kr[i] = *(const u32x4*)(ksrc + (size_t)i * 64 * 1024 + (dc + 1) * 64);
        }
        bf16x8 qf[4];
#pragma unroll
        for (int d0 = 0; d0 < 4; ++d0) qf[d0] = *(const bf16x8*)(Q2 + tok * 1024 + hd * 256 + dc * 64 + d0 * 16 + hi * 8);
        const LAS unsigned char* Kb = lds + (dc & 1) * XK_BYTES;
#pragma unroll
        for (int d0 = 0; d0 < 4; ++d0)
#pragma unroll
            for (int j = 0; j < 8; ++j) { const bf16x8 kf = *(const LAS bf16x8*)(Kb + (32 * j + r32) * KP + d0 * 32 + hi * 16); s[j] = __builtin_amdgcn_mfma_f32_32x32x16_bf16(kf, qf[d0], s[j], 0, 0, 0); }
        if (dc < 3) {
#pragma unroll
            for (int i = 0; i < 4; ++i) *(LAS u32x4*)(lds + ((dc + 1) & 1) * XK_BYTES + kdst + i * 64 * KP) = kr[i];
        } else {
#pragma unroll
            for (int i = 0; i < 2; ++i) vr[i] = *(const u32x4*)(vsrc + (size_t)i * 16 * MT);
#pragma unroll
            for (int i = 0; i < 2; ++i) { *(LAS u32x2*)(lds + vdst + i * 16 * XVP) = (u32x2){vr[i].x, vr[i].y}; *(LAS u32x2*)(lds + vdst + i * 16 * XVP + 8) = (u32x2){vr[i].z, vr[i].w}; }
        }
        __syncthreads();
    }
    float mx = s[0][0];
#pragma unroll
    for (int j = 0; j < 8; ++j)
#pragma unroll
        for (int r = 0; r < 16; ++r) mx = fmaxf(mx, s[j][r]);
    mx = fmaxf(mx, __shfl_xor(mx, 32));
    float l = 0.f;
    bf16x8 pa[8][2];
#pragma unroll
    for (int j = 0; j < 8; ++j) {
#pragma unroll
        for (int r = 0; r < 16; ++r) { s[j][r] = __builtin_amdgcn_exp2f(s[j][r] - mx); l += s[j][r]; }
        u32x4 w;
        w.x = pk2(s[j][0], s[j][1]); w.y = pk2(s[j][2], s[j][3]); w.z = pk2(s[j][4], s[j][5]); w.w = pk2(s[j][6], s[j][7]); pa[j][0] = __builtin_bit_cast(bf16x8, w);
        w.x = pk2(s[j][8], s[j][9]); w.y = pk2(s[j][10], s[j][11]); w.z = pk2(s[j][12], s[j][13]); w.w = pk2(s[j][14], s[j][15]); pa[j][1] = __builtin_bit_cast(bf16x8, w);
    }
    l += __shfl_xor(l, 32);
    const float inv = 1.f / l;
#pragma unroll 1
    for (int ds = 0; ds < 8; ++ds) {
        if (ds < 7) {
#pragma unroll
            for (int i = 0; i < 2; ++i) vr[i] = *(const u32x4*)(vsrc + (size_t)(i * 16 + (ds + 1) * 32) * MT);
        }
        const LAS unsigned char* Vb = lds + XV_OFF + (ds & 1) * XV_BYTES;
        f32x16 o = {};
#pragma unroll
        for (int j = 0; j < 8; ++j)
#pragma unroll
            for (int hf = 0; hf < 2; ++hf) { const int kb2 = (32 * j + 16 * hf + 4 * hi) * 2;
                const u32x2 a0 = *(const LAS u32x2*)(Vb + r32 * XVP + kb2), a1 = *(const LAS u32x2*)(Vb + r32 * XVP + kb2 + 16);
                const bf16x8 va = __builtin_bit_cast(bf16x8, (u32x4){a0.x, a0.y, a1.x, a1.y});
                o = __builtin_amdgcn_mfma_f32_32x32x16_bf16(va, pa[j][hf], o, 0, 0, 0); }
        bf16_t* op = O2 + tok * 1024 + hd * 256 + ds * 32 + 4 * hi;
#pragma unroll
        for (int g = 0; g < 4; ++g) { u32x2 w; w.x = pk2(o[4 * g] * inv, o[4 * g + 1] * inv); w.y = pk2(o[4 * g + 2] * inv, o[4 * g + 3] * inv); *(u32x2*)(op + 8 * g) = w; }
        if (ds < 7) {
#pragma unroll
            for (int i = 0; i < 2; ++i) { *(LAS u32x2*)(lds + vdst + ((ds + 1) & 1) * XV_BYTES + i * 16 * XVP) = (u32x2){vr[i].x, vr[i].y}; *(LAS u32x2*)(lds + vdst + ((ds + 1) & 1) * XV_BYTES + i * 16 * XVP + 8) = (u32x2){vr[i].z, vr[i].w}; }
        }
        __syncthreads();
    }
}

template <bool TWO, bool NEXT>
__device__ __forceinline__ void row_pass(const Args& a, const float* xin, const bf16_t* ya, const bf16_t* yb, const float* g_post, const float* g_pre, int lane, int gw, int NGW) {
    const bf16_t* YF = (const bf16_t*)(a.ws + WS_YF); const bf16_t* YC = (const bf16_t*)(a.ws + WS_YC); bf16_t* H = (bf16_t*)(a.ws + WS_H);
    f32x4 gp[4], gn[4];
#pragma unroll
    for (int j = 0; j < 4; ++j) { gp[j] = ((const f32x4*)g_post)[lane + 64 * j]; if (NEXT) gn[j] = ((const f32x4*)g_pre)[lane + 64 * j]; }
    for (int m = gw; m < T_; m += NGW) {
        float rf = 1.f, rc = 1.f;
        if (TWO) {
            const u32x4 f = *((const u32x4*)(YF + (size_t)m * 512) + lane), c = *((const u32x4*)(YC + (size_t)m * 512) + lane);
            float sf = 0.f, sc = 0.f;
#pragma unroll
            for (int e = 0; e < 4; ++e) { const float f0 = bflo(f[e]), f1 = bfhi(f[e]), c0 = bflo(c[e]), c1 = bfhi(c[e]); sf += f0 * f0 + f1 * f1; sc += c0 * c0 + c1 * c1; }
            rf = rsqrtf(wave_sum(sf) * (1.f / 512.f) + EPS); rc = rsqrtf(wave_sum(sc) * (1.f / 512.f) + EPS);
        }
        f32x4 y[4]; float ss = 0.f;
#pragma unroll
        for (int j = 0; j < 4; ++j) {
            const u32x2 p = *((const u32x2*)(ya + (size_t)m * D_) + lane + 64 * j);
            y[j] = (f32x4){bflo(p.x), bfhi(p.x), bflo(p.y), bfhi(p.y)};
            if (TWO) { const u32x2 p2 = *((const u32x2*)(yb + (size_t)m * D_) + lane + 64 * j); y[j] = y[j] * rf + (f32x4){bflo(p2.x), bfhi(p2.x), bflo(p2.y), bfhi(p2.y)} * rc; }
            ss += (y[j].x * y[j].x + y[j].y * y[j].y) + (y[j].z * y[j].z + y[j].w * y[j].w);
        }
        const float r = rsqrtf(wave_sum(ss) * (1.f / D_) + EPS);
        const f32x4* xr = (const f32x4*)(xin + (size_t)m * D_) + lane; f32x4* xo = (f32x4*)(a.out + (size_t)m * D_) + lane;
        float s2 = 0.f;
#pragma unroll
        for (int j = 0; j < 4; ++j) { y[j] = xr[64 * j] + y[j] * r * gp[j]; xo[64 * j] = y[j]; s2 += (y[j].x * y[j].x + y[j].y * y[j].y) + (y[j].z * y[j].z + y[j].w * y[j].w); }
        if (NEXT) {
            const float r2 = rsqrtf(wave_sum(s2) * (1.f / D_) + EPS);
            u32x2* o8 = (u32x2*)(H + (size_t)m * D_) + lane;
#pragma unroll
            for (int j = 0; j < 4; ++j) { const f32x4 h = y[j] * r2 * gn[j]; u32x2 w; w.x = pk2(h.x, h.y); w.y = pk2(h.z, h.w); o8[64 * j] = w; }
        }
    }
}

template <int ACT>
__device__ __forceinline__ void run_gemm(LAS unsigned char* lds, const bf16_t* A, const bf16_t* Bt, int M, int N, int K, bf16_t* O, int ldc, int G, int c) {
    pg8::Gemm g{A, Bt, M, N, K}; pg8::StaticOrder S; S.init(M, N, G, c);
    pg8::EpiStore<ACT> E{O, ldc};
    pg8::gemm_phase<pg8::EpiStore<ACT>, pg8::StaticOrder, PG8_ALIGN, PG8_SP2>(lds, g, S, E);
    __syncthreads();
}

__global__ void __launch_bounds__(512) fwd_kernel(Args a) {
    extern __shared__ __attribute__((aligned(16))) unsigned char lds_raw[];
    LAS unsigned char* lds = (LAS unsigned char*)lds_raw;
    const int tid = threadIdx.x, lane = tid & 63, wid = __builtin_amdgcn_readfirstlane(tid >> 6);
    const int G = gridDim.x, bx = blockIdx.x;
    const int gw = bx * 8 + wid, NGW = G * 8;
    unsigned char* ws = a.ws;
    const int lo = a.ph_lo, hi = a.ph_hi;
#define IN(k) (lo <= (k) && (k) < hi)
#define SEAM(k) do { if (IN(k) && IN((k) + 1)) cg::this_grid().sync(); } while (0)
    bf16_t* H = (bf16_t*)(ws + WS_H);

    if (IN(0)) { p0_prep(a, lds, tid, lane, wid, gw, NGW); }
    SEAM(0);
    if (IN(1)) {
        if (bx >= 64 && bx < 128) cumsum_bh(a, lds, bx - 64, tid, lane, wid);
        run_gemm<0>(lds, H, (const bf16_t*)(ws + WS_WA), T_, 2048, 1024, (bf16_t*)(ws + WS_QK), 2048, G, bx);
        run_gemm<0>(lds, (const bf16_t*)(ws + WS_WV), H, 1024, T_, 1024, (bf16_t*)(ws + WS_VT), T_, G, bx);
    }
    SEAM(1);
    if (IN(2)) {
        run_gemm<0>(lds, (const bf16_t*)(ws + WS_MEMN), (const bf16_t*)(ws + WS_WMK), MT, 1024, 1024, (bf16_t*)(ws + WS_MEMK), 1024, G, bx);
        run_gemm<0>(lds, (const bf16_t*)(ws + WS_WMV), (const bf16_t*)(ws + WS_MEMN), 1024, MT, 1024, (bf16_t*)(ws + WS_MEMVT), MT, G, (bx + G - 32) % G);
        unsigned* ctr = (unsigned*)(ws + WS_CTL);
        LAS int* uq = (LAS int*)(lds + 131072);
        for (;;) {
            if (tid == 0) *uq = (int)atomicAdd(ctr, 1u);
            __syncthreads();
            int u = *uq;
            __syncthreads();
            if (u >= 1024) break;
            int mode, qb, bh;
            if (u < 320) { mode = 0; qb = 7 - (u >> 6); bh = u & 63; }
            else if (u < 704) { const int j = u - 320; mode = 1; qb = 2 + (j >> 6); bh = j & 63; }
            else if (u < 768) { mode = 0; qb = 2; bh = u & 63; }
            else if (u < 832) { mode = 0; qb = 1; bh = u & 63; }
            else if (u < 896) { mode = 1; qb = 1; bh = u & 63; }
            else if (u < 960) { mode = 0; qb = 0; bh = u & 63; }
            else { mode = 1; qb = 0; bh = u & 63; }
            if (mode == 0) attn_unit<0>(a, lds, bh >> 3, bh & 7, qb, tid, lane, wid);
            else attn_unit<1>(a, lds, bh >> 3, bh & 7, qb, tid, lane, wid);
        }
    }
    SEAM(2);
    if (IN(3)) {
        run_gemm<0>(lds, (const bf16_t*)(ws + WS_YF), (const bf16_t*)(ws + WS_WOF), T_, 1024, 512, (bf16_t*)(ws + WS_Y1A), 1024, G, bx);
        run_gemm<0>(lds, (const bf16_t*)(ws + WS_YC), (const bf16_t*)(ws + WS_WOC), T_, 1024, 512, (bf16_t*)(ws + WS_Y1B), 1024, G, bx);
    }
    SEAM(3);
    if (IN(4)) row_pass<true, true>(a, a.x, (const bf16_t*)(ws + WS_Y1A), (const bf16_t*)(ws + WS_Y1B), a.g_mix_post, a.g_mem_pre, lane, gw, NGW);
    SEAM(4);
    if (IN(5)) run_gemm<0>(lds, H, (const bf16_t*)(ws + WS_WMQ), T_, 1024, 1024, (bf16_t*)(ws + WS_Q2), 1024, G, bx);
    SEAM(5);
    if (IN(6)) { for (int u = bx; u < 256; u += G) xattn_unit(a, lds, u >> 5, (u >> 3) & 3, u & 7, tid, lane, wid); }
    SEAM(6);
    if (IN(7)) run_gemm<0>(lds, (const bf16_t*)(ws + WS_O2), (const bf16_t*)(ws + WS_WMO), T_, 1024, 1024, (bf16_t*)(ws + WS_Y2), 1024, G, bx);
    SEAM(7);
    if (IN(8)) row_pass<false, true>(a, a.out, (const bf16_t*)(ws + WS_Y2), nullptr, a.g_mem_post, a.g_ff_pre, lane, gw, NGW);
    SEAM(8);
    if (IN(9)) run_gemm<2>(lds, H, (const bf16_t*)(ws + WS_WF1), T_, FF, 1024, (bf16_t*)(ws + WS_FFH), FF, G, bx);
    SEAM(9);
    if (IN(10)) run_gemm<0>(lds, (const bf16_t*)(ws + WS_FFH), (const bf16_t*)(ws + WS_WF2), T_, 1024, FF, (bf16_t*)(ws + WS_Y3), 1024, G, bx);
    SEAM(10);
    if (IN(11)) row_pass<false, false>(a, a.out, (const bf16_t*)(ws + WS_Y3), nullptr, a.g_ff_post, nullptr, lane, gw, NGW);
#undef IN
#undef SEAM
}

constexpr int N_PHASES = 12;

extern "C" void kernel_launch(void* const* d_in, const int* in_sizes, int n_in, void* d_out, int out_size, void* d_ws, size_t ws_size, hipStream_t stream) {
    static int grid = 0;
    if (grid == 0) {
        if (n_in != 21 || out_size != T_ * D_ || ws_size < WS_END) { fprintf(stderr, "kernel_launch: unexpected shapes (n_in %d out %d ws %zu)\n", n_in, out_size, ws_size); grid = -1; return; }
        int dev = 0, cus = 0, per_cu = 0;
        hipGetDevice(&dev); hipDeviceGetAttribute(&cus, hipDeviceAttributeMultiprocessorCount, dev);
        if (hipFuncSetAttribute((const void*)fwd_kernel, hipFuncAttributeMaxDynamicSharedMemorySize, LDS_BYTES) != hipSuccess) { fprintf(stderr, "kernel_launch: hipFuncSetAttribute failed\n"); grid = -1; return; }
        if (hipOccupancyMaxActiveBlocksPerMultiprocessor(&per_cu, (const void*)fwd_kernel, 512, LDS_BYTES) != hipSuccess || per_cu < 1) { fprintf(stderr, "kernel_launch: occupancy query says %d\n", per_cu); per_cu = 1; }
        (void)hipGetLastError();
        grid = cus * 1;
        if (grid <= 0) grid = 256;
    }
    if (grid < 0) return;
    hipMemsetAsync((char*)d_ws + WS_CTL, 0, 4096, stream);
    Args a{};
    const float** p = (const float**)&a;
    for (int i = 0; i < 21; ++i) p[i] = (const float*)d_in[i];
    a.out = (float*)d_out; a.ws = (unsigned char*)d_ws;
#if MK_MULTI
    for (int ph = 0; ph < N_PHASES; ++ph) { const int reps = ((REP_MASK >> ph) & 1) ? 1 + REP_N : 1;
        for (int rp = 0; rp < reps; ++rp) { if (ph == 2) hipMemsetAsync((char*)d_ws + WS_CTL, 0, 4096, stream); a.ph_lo = ph; a.ph_hi = ph + 1; hipLaunchKernelGGL(fwd_kernel, dim3(grid), dim3(512), LDS_BYTES, stream, a); } }
#else
    a.ph_lo = 0; a.ph_hi = N_PHASES;
    void* args[] = {&a};
    hipError_t e = hipLaunchCooperativeKernel((const void*)fwd_kernel, dim3(grid), dim3(512), args, LDS_BYTES, stream);
    if (e != hipSuccess) fprintf(stderr, "cooperative launch failed: %s (grid %d)\n", hipGetErrorString(e), grid);
#endif
}
```

```cpp
#include <hip/hip_runtime.h>
#include <hip/hip_cooperative_groups.h>
#include <cstdio>
#include <cstdint>
namespace cg = cooperative_groups;
namespace pg8 {
#define PG8_LAS __attribute__((address_space(3)))
typedef unsigned short bf16_t;
typedef short bf16x8 __attribute__((ext_vector_type(8)));
typedef float f32x4 __attribute__((ext_vector_type(4)));
typedef unsigned u32x4 __attribute__((ext_vector_type(4)));
constexpr int BM = 256, BK = 64, HALF = 128, HTB = HALF * BK * 2  , STAGE_BYTES = 8 * HTB, NXCD = 8, WGM = 8;

__host__ __device__ __forceinline__ int lds_byte(int r, int c) { const int st = (r >> 4) * 2 + (c >> 5), rr = r & 15, cc = c & 31, ob = rr * 64 + cc * 2; return st * 1024 + (ob ^ (((ob >> 9) & 1) << 5)); }
__host__ __device__ __forceinline__ void stage_rc(int b, int& R, int& C) { const int st = b / 1024, sb = b % 1024, swz = sb ^ (((sb >> 9) & 1) << 5); R = (st >> 1) * 16 + swz / 64; C = (st & 1) * 32 + (swz % 64) / 2; }
__host__ __device__ __forceinline__ int perm32(int rho) { const int n = rho >> 4, i = rho & 15; return 8 * (i >> 2) + 4 * n + (i & 3); }

struct Unit { int pm, pn; };
struct Gemm { const bf16_t* A; const bf16_t* Bt; int M, N, K; };

struct StaticOrder {
    int nM, nN, nwg, G, c;
    __host__ __device__ void init(int M, int N, int G_, int c_) { nM = M / BM; nN = N / BM; nwg = nM * nN; G = G_; c = c_; }
    __host__ __device__ bool next(int i, Unit& u) const {
        const long L = (long)i * G + c; if (L >= nwg) return false;
        int wgid = (int)L; { const int q = nwg / NXCD, r = nwg % NXCD, xcd = wgid % NXCD, off = wgid / NXCD; wgid = (xcd < r ? xcd * (q + 1) : r * (q + 1) + (xcd - r) * q) + off; }
        const int nig = WGM * nN, gid = wgid / nig, fm = gid * WGM, gsz = (nM - fm) < WGM ? (nM - fm) : WGM;
        u.pm = fm + ((wgid % nig) % gsz); u.pn = (wgid % nig) / gsz; return true;
    }
    __device__ __forceinline__ void a_ready(const Unit&) const {}
    __device__ __forceinline__ void done(const Unit&) const {}
};

__device__ __forceinline__ unsigned cvt_pk_bf16(float lo, float hi) { unsigned r; asm volatile("v_cvt_pk_bf16_f32 %0, %1, %2" : "=v"(r) : "v"(lo), "v"(hi)); return r; }
typedef float f32x2 __attribute__((ext_vector_type(2)));
struct OneUnit { Unit u;
    __device__ __forceinline__ bool next(int i, Unit& o) const { if (i != 0) return false; o = u; return true; }
    __device__ __forceinline__ void a_ready(const Unit&) const {}
    __device__ __forceinline__ void done(const Unit&) const {} };
template <int ACT  > struct EpiStore {
    static constexpr bool PERM = true, AFTER_DRAIN = false;
    bf16_t* O; int ldc;
    __device__ __forceinline__ void operator()(const f32x4 (&acc)[2][2][4][2], const Unit& u, int wr, int wc, int fr, int fq) const {
        const int row0 = u.pm * BM + wr * 64 + fr; const int col0 = u.pn * BM + wc * 32 + 8 * fq;
#pragma unroll
        for (int ai = 0; ai < 2; ++ai)
#pragma unroll
            for (int m = 0; m < 4; ++m) { bf16_t* rowp = O + (size_t)(row0 + ai * HALF + m * 16) * ldc + col0;
#pragma unroll
                for (int bj = 0; bj < 2; ++bj) { f32x4 v0 = acc[ai][bj][m][0], v1 = acc[ai][bj][m][1];
                    if (ACT == 2) {
#pragma unroll
                        for (int e = 0; e < 4; ++e) { float a = v0[e] > 0.f ? v0[e] : 0.f; v0[e] = a * a; float b = v1[e] > 0.f ? v1[e] : 0.f; v1[e] = b * b; } }
                    u32x4 w; w.x = cvt_pk_bf16(v0[0], v0[1]); w.y = cvt_pk_bf16(v0[2], v0[3]); w.z = cvt_pk_bf16(v1[0], v1[1]); w.w = cvt_pk_bf16(v1[2], v1[3]);
                    *(u32x4*)(rowp + bj * HALF) = w; } }
    }
};
template <class Epi, class Sched, bool ALIGN_EPI = false, bool SP2 = false>
__device__ __forceinline__ void gemm_phase(PG8_LAS unsigned char* lds, const Gemm g, const Sched& S, const Epi& E) {
    const int tid = threadIdx.x, wid = __builtin_amdgcn_readfirstlane(tid >> 6), lane = tid & 63, wr = wid >> 2, wc = wid & 3, fr = lane & 15, fq = lane >> 4;
    const int K = g.K, nt = K / BK;
    unsigned voffA[2], voffB[2];
#pragma unroll
    for (int i = 0; i < 2; ++i) { int R, C; stage_rc(tid * 16 + i * 8192, R, C); const int Rb = Epi::PERM ? ((R & ~31) + perm32(R & 31)) : R;
        voffA[i] = (unsigned)(R * K + C) * 2u; voffB[i] = (unsigned)(Rb * K + C) * 2u; }
    const size_t kstep = (size_t)(BK * 2);
    const size_t hstep = (size_t)HALF * K * 2;
    const size_t tstep = 2 * hstep;
    const unsigned ldsw = (unsigned)wid * 1024u;
    const int aoff = lds_byte(wr * 64 + fr, fq * 8), boff = lds_byte(wc * 32 + fr, fq * 8);
#define PG8_SA(b, h) (((b) * 2 + (h)) * HTB)
#define PG8_SB(b, h) ((4 + (b) * 2 + (h)) * HTB)
#define PG8_STAGE(bufoff, gbase, voff) do { _Pragma("unroll") for (int _i = 0; _i < 2; ++_i) \
        __builtin_amdgcn_global_load_lds((const unsigned*)((const char*)(gbase) + (voff)[_i]), (PG8_LAS unsigned*)(lds + (bufoff) + ldsw + _i * 8192), 16, 0, 0); } while (0)
#define PG8_LDA(dst, b, h) do { _Pragma("unroll") for (int m = 0; m < 4; ++m) _Pragma("unroll") for (int k = 0; k < 2; ++k) dst[m][k] = *(const PG8_LAS bf16x8*)(lds + PG8_SA(b, h) + aoff + m * 2048 + k * 1024); } while (0)
#define PG8_LDB(dst, b, h) do { _Pragma("unroll") for (int n = 0; n < 2; ++n) _Pragma("unroll") for (int k = 0; k < 2; ++k) dst[n][k] = *(const PG8_LAS bf16x8*)(lds + PG8_SB(b, h) + boff + n * 2048 + k * 1024); } while (0)
#define PG8_MMA(ai, bj, At, Bt) do { __builtin_amdgcn_s_setprio(1); _Pragma("unroll") for (int m = 0; m < 4; ++m) _Pragma("unroll") for (int n = 0; n < 2; ++n) _Pragma("unroll") for (int k = 0; k < 2; ++k) \
        acc[ai][bj][m][n] = __builtin_amdgcn_mfma_f32_16x16x32_bf16(Bt[n][k], At[m][k], acc[ai][bj][m][n], 0, 0, 0); __builtin_amdgcn_s_setprio(0); } while (0)
#define PG8_WAIT_V(n) asm volatile("s_waitcnt vmcnt(" #n ")" ::: "memory")
#define PG8_WAIT_L(n) asm volatile("s_waitcnt lgkmcnt(" #n ")" ::: "memory")
#define PG8_BAR __builtin_amdgcn_s_barrier()
#define PG8_SCHED __builtin_amdgcn_sched_barrier(0)
    Unit cur, nxt; int ui = 0;
    if (!S.next(0, cur)) return;
    f32x4 acc[2][2][4][2];
#pragma unroll
    for (int a = 0; a < 2; ++a)
#pragma unroll
        for (int b = 0; b < 2; ++b)
#pragma unroll
            for (int m = 0; m < 4; ++m)
#pragma unroll
                for (int n = 0; n < 2; ++n) acc[a][b][m][n] = (f32x4){0.f, 0.f, 0.f, 0.f};
    bf16x8 At[4][2], B0[2][2], B1[2][2];
    const char* cA = (const char*)g.A + (size_t)cur.pm * tstep; const char* cB = (const char*)g.Bt + (size_t)cur.pn * tstep;
    S.a_ready(cur);
    if constexpr (SP2) {
        PG8_STAGE(PG8_SB(0, 0), cB, voffB); PG8_STAGE(PG8_SB(0, 1), cB + hstep, voffB); PG8_STAGE(PG8_SA(0, 0), cA, voffA); PG8_STAGE(PG8_SA(0, 1), cA + hstep, voffA);
        if (wr == 1) PG8_BAR;
        PG8_WAIT_V(2); PG8_BAR;
        PG8_STAGE(PG8_SB(1, 0), cB + kstep, voffB); PG8_STAGE(PG8_SA(1, 0), cA + kstep, voffA); PG8_STAGE(PG8_SB(1, 1), cB + hstep + kstep, voffB);
        PG8_WAIT_V(6); PG8_BAR;
    } else {
        PG8_STAGE(PG8_SB(0, 0), cB, voffB); PG8_STAGE(PG8_SA(0, 0), cA, voffA); PG8_STAGE(PG8_SB(0, 1), cB + hstep, voffB); PG8_STAGE(PG8_SA(0, 1), cA + hstep, voffA);
        if (wr == 1) PG8_BAR;
        PG8_WAIT_V(4); PG8_BAR;
        PG8_STAGE(PG8_SB(1, 0), cB + kstep, voffB); PG8_STAGE(PG8_SA(1, 0), cA + kstep, voffA); PG8_STAGE(PG8_SB(1, 1), cB + hstep + kstep, voffB);
        PG8_WAIT_V(6); PG8_BAR;
    }
    for (;;) {
        const bool has_next = S.next(ui + 1, nxt);
        const char* nA = has_next ? (const char*)g.A + (size_t)nxt.pm * tstep : cA; const char* nB = has_next ? (const char*)g.Bt + (size_t)nxt.pn * tstep : cB;
        for (int t = 0; t < nt; t += 2) {
            const bool last = (t == nt - 2);
            const char* a1 = cA + (size_t)(t + 1) * kstep;
            const char* a2 = last ? nA : cA + (size_t)(t + 2) * kstep; const char* b2 = last ? nB : cB + (size_t)(t + 2) * kstep;
            const char* a3 = a2 + kstep; const char* b3 = b2 + kstep;
            if (last && has_next) S.a_ready(nxt);
            if constexpr (SP2) {
            PG8_LDB(B0, 0, 0); PG8_LDB(B1, 0, 1); PG8_SCHED; PG8_LDA(At, 0, 0); PG8_STAGE(PG8_SA(1, 1), a1 + hstep, voffA);
            PG8_WAIT_V(8); PG8_WAIT_L(0); PG8_BAR; PG8_MMA(0, 0, At, B0); PG8_MMA(0, 1, At, B1); PG8_BAR; PG8_SCHED;
            PG8_LDA(At, 0, 1); PG8_STAGE(PG8_SB(0, 0), b2, voffB); PG8_STAGE(PG8_SB(0, 1), b2 + hstep, voffB); PG8_STAGE(PG8_SA(0, 0), a2, voffA);
            PG8_WAIT_V(8); PG8_WAIT_L(0); PG8_BAR; PG8_MMA(1, 0, At, B0); PG8_MMA(1, 1, At, B1); PG8_BAR; PG8_SCHED;
            PG8_LDB(B0, 1, 0); PG8_LDB(B1, 1, 1); PG8_SCHED; PG8_LDA(At, 1, 0); PG8_STAGE(PG8_SA(0, 1), a2 + hstep, voffA);
            PG8_WAIT_V(8); PG8_WAIT_L(0); PG8_BAR; PG8_MMA(0, 0, At, B0); PG8_MMA(0, 1, At, B1); PG8_BAR; PG8_SCHED;
            PG8_LDA(At, 1, 1); PG8_STAGE(PG8_SB(1, 0), b3, voffB); PG8_STAGE(PG8_SB(1, 1), b3 + hstep, voffB); PG8_STAGE(PG8_SA(1, 0), a3, voffA);
            PG8_WAIT_V(8); PG8_WAIT_L(0); PG8_BAR; PG8_MMA(1, 0, At, B0); PG8_MMA(1, 1, At, B1); PG8_BAR; PG8_SCHED;
            } else {
            PG8_LDB(B0, 0, 0); PG8_SCHED; PG8_LDA(At, 0, 0); PG8_STAGE(PG8_SA(1, 1), a1 + hstep, voffA);
            PG8_WAIT_L(8); PG8_BAR; PG8_WAIT_L(0); PG8_MMA(0, 0, At, B0); PG8_BAR; PG8_SCHED;
            PG8_LDB(B1, 0, 1); PG8_STAGE(PG8_SB(0, 0), b2, voffB);
            PG8_BAR; PG8_WAIT_L(0); PG8_MMA(0, 1, At, B1); PG8_BAR;
            PG8_LDA(At, 0, 1); PG8_STAGE(PG8_SA(0, 0), a2, voffA);
            PG8_BAR; PG8_WAIT_L(0); PG8_MMA(1, 0, At, B0); PG8_BAR; PG8_SCHED;
            PG8_STAGE(PG8_SB(0, 1), b2 + hstep, voffB);
            PG8_WAIT_V(6); PG8_BAR; PG8_MMA(1, 1, At, B1); PG8_BAR;
            PG8_LDB(B0, 1, 0); PG8_SCHED; PG8_LDA(At, 1, 0); PG8_STAGE(PG8_SA(0, 1), a2 + hstep, voffA);
            PG8_WAIT_L(8); PG8_BAR; PG8_WAIT_L(0); PG8_MMA(0, 0, At, B0); PG8_BAR; PG8_SCHED;
            PG8_LDB(B1, 1, 1); PG8_STAGE(PG8_SB(1, 0), b3, voffB);
            PG8_BAR; PG8_WAIT_L(0); PG8_MMA(0, 1, At, B1); PG8_BAR;
            PG8_LDA(At, 1, 1); PG8_STAGE(PG8_SA(1, 0), a3, voffA);
            PG8_BAR; PG8_WAIT_L(0); PG8_MMA(1, 0, At, B0); PG8_BAR; PG8_SCHED;
            PG8_STAGE(PG8_SB(1, 1), b3 + hstep, voffB);
            PG8_WAIT_V(6); PG8_BAR; PG8_MMA(1, 1, At, B1); PG8_BAR;
            }
        }
        if constexpr (ALIGN_EPI) { if (wr == 0) PG8_BAR; }
        if constexpr (!Epi::AFTER_DRAIN) { E(acc, cur, wr, wc, fr, fq); S.done(cur); }
        if (!has_next) break;
#pragma unroll
        for (int a = 0; a < 2; ++a)
#pragma unroll
            for (int b = 0; b < 2; ++b)
#pragma unroll
                for (int m = 0; m < 4; ++m)
#pragma unroll
                    for (int n = 0; n < 2; ++n) acc[a][b][m][n] = (f32x4){0.f, 0.f, 0.f, 0.f};
        cur = nxt; cA = nA; cB = nB; ++ui;
        if constexpr (ALIGN_EPI) { if (wr == 1) PG8_BAR; }
    }
    PG8_WAIT_V(0);
    if constexpr (!ALIGN_EPI) { if (wr == 0) PG8_BAR; }
    PG8_BAR;
    if constexpr (Epi::AFTER_DRAIN) { E.fused(acc, cur, wr, wc, fr, fq, lds, wid, lane); S.done(cur); }
#undef PG8_SA
#undef PG8_SB
#undef PG8_STAGE
#undef PG8_LDA
#undef PG8_LDB
#undef PG8_MMA
#undef PG8_WAIT_V
#undef PG8_WAIT_L
#undef PG8_BAR
#undef PG8_SCHED
}
}
#ifndef PG8_SP2
#define PG8_SP2 true
#endif
#ifndef PG8_ALIGN
#define PG8_ALIGN true
#endif
#ifndef MK_MULTI
#define MK_MULTI 0
#endif

#ifndef REP_MASK
#define REP_MASK 0
#endif
#ifndef REP_N
#define REP_N 1
#endif
#define LAS __attribute__((address_space(3)))
typedef unsigned short bf16_t;
typedef short bf16x8 __attribute__((ext_vector_type(8)));
typedef short s16x4 __attribute__((ext_vector_type(4)));
typedef float f32x4 __attribute__((ext_vector_type(4)));
typedef float f32x16 __attribute__((ext_vector_type(16)));
typedef unsigned u32x4 __attribute__((ext_vector_type(4)));
typedef unsigned u32x2 __attribute__((ext_vector_type(2)));

constexpr int T_ = 16384, D_ = 1024, S_ = 2048, NB = 8, MT = 2048, FF = 4096, DIN = 3080;
constexpr float LOG2E = 1.4426950408889634f;
constexpr float C2Q = 0.125f * LOG2E, C2M = 0.0625f * LOG2E, EPS = 1e-6f;

constexpr size_t MiB = 1u << 20;
constexpr size_t WS_CTL = 0;
constexpr size_t WS_WA = 2 * MiB, WS_WV = 6 * MiB, WS_WOF = 8 * MiB, WS_WOC = 9 * MiB, WS_WMQ = 10 * MiB, WS_WMK = 12 * MiB, WS_WMV = 14 * MiB, WS_WMO = 16 * MiB;
constexpr size_t WS_WF1 = 18 * MiB, WS_WF2 = 26 * MiB;
constexpr size_t WS_H = 36 * MiB;
constexpr size_t WS_QK = 68 * MiB;
constexpr size_t WS_VT = 132 * MiB;
constexpr size_t WS_YF = 164 * MiB, WS_YC = 180 * MiB;
constexpr size_t WS_MEMN = 196 * MiB, WS_MEMK = 200 * MiB, WS_MEMVT = 204 * MiB;
constexpr size_t WS_LOGF = 208 * MiB, WS_C2 = 209 * MiB;
constexpr size_t WS_Y1A = 68 * MiB, WS_Y1B = 100 * MiB;
constexpr size_t WS_Q2 = 68 * MiB, WS_O2 = 100 * MiB, WS_Y2 = 132 * MiB;
constexpr size_t WS_FFH = 68 * MiB;
constexpr size_t WS_Y3 = 210 * MiB;
constexpr size_t WS_END = 242 * MiB;

constexpr int LDS_BYTES = 131072 + 1024;

struct Args {
    const float *x, *mem, *w_in, *b_fgt, *rel_bias, *g_fox_out, *g_chk_out, *w_out, *g_mix_pre, *g_mix_post, *g_mem_kv,
                *w_mq, *w_mk, *w_mv, *w_mo, *g_mem_pre, *g_mem_post, *w_ff1, *w_ff2, *g_ff_pre, *g_ff_post;
    float* out; unsigned char* ws; int ph_lo, ph_hi;
};

__device__ __forceinline__ float wave_sum(float v) {
#pragma unroll
    for (int o = 1; o < 64; o <<= 1) v += __shfl_xor(v, o);
    return v;
}
__device__ __forceinline__ unsigned pk2(float lo, float hi) { return pg8::cvt_pk_bf16(lo, hi); }
__device__ __forceinline__ float bflo(unsigned u) { return __uint_as_float(u << 16); }
__device__ __forceinline__ float bfhi(unsigned u) { return __uint_as_float(u & 0xffff0000u); }

__device__ __forceinline__ void p0_prep(const Args& a, LAS unsigned char* lds, int tid, int lane, int wid, int gw, int NGW) {
    unsigned char* ws = a.ws;
    LAS float* wf = (LAS float*)(lds + 73728);
    for (int i = tid; i < 8192; i += 512) { const int k = i >> 3, j = i & 7; wf[i] = a.w_in[(size_t)k * DIN + 1536 + j]; }
    __syncthreads();
    LAS float* scr = (LAS float*)(lds + wid * 8448);
    for (int it = gw; it < 8192; it += NGW) {
        int r = it; const float* W; int ldw, scol, nb, ldt, drow0 = 0; bf16_t* WT; float cs = 1.f; const float* ks = nullptr;
        if (r < 1536) { const int j = r >> 8; r &= 255; W = a.w_in; ldw = DIN; nb = 16; ldt = 1024;
            scol = j == 0 ? 0 : j == 1 ? 512 : j == 2 ? 1544 : j == 3 ? 2056 : j == 4 ? 1024 : 2568;
            WT = (bf16_t*)(ws + (j < 4 ? WS_WA : WS_WV)); drow0 = j < 4 ? j * 512 : (j - 4) * 512; cs = (j == 0 || j == 2) ? C2Q : 1.f; }
        else if (r < 2048) { r -= 1536; const int j = r >> 8; r &= 255; W = a.w_out + (size_t)j * 512 * 1024; ldw = 1024; scol = 0; nb = 32; ldt = 512;
            WT = (bf16_t*)(ws + (j ? WS_WOC : WS_WOF)); ks = j ? a.g_chk_out : a.g_fox_out; }
        else if (r < 4096) { r -= 2048; const int j = r >> 9; r &= 511; W = j == 0 ? a.w_mq : j == 1 ? a.w_mk : j == 2 ? a.w_mv : a.w_mo; ldw = 1024; scol = 0; nb = 32; ldt = 1024;
            WT = (bf16_t*)(ws + WS_WMQ + (size_t)j * 2 * MiB); cs = j == 0 ? C2M : 1.f; }
        else if (r < 6144) { r -= 4096; W = a.w_ff1; ldw = 4096; scol = 0; nb = 128; ldt = 1024; WT = (bf16_t*)(ws + WS_WF1); }
        else { r -= 6144; W = a.w_ff2; ldw = 1024; scol = 0; nb = 32; ldt = 4096; WT = (bf16_t*)(ws + WS_WF2); }
        const int kb = r / nb, nbi = r % nb, k0 = 64 * kb, n0 = 32 * nbi;
        { f32x4 tv[8]; const int c4 = (lane & 7) * 4;
#pragma unroll
          for (int i = 0; i < 8; ++i) { const int kk = 8 * i + (lane >> 3); tv[i] = *(const f32x4*)(W + (size_t)(k0 + kk) * ldw + scol + n0 + c4); }
#pragma unroll
          for (int i = 0; i < 8; ++i) { const int kk = 8 * i + (lane >> 3); const float sc = ks ? ks[k0 + kk] * cs : cs; LAS float* d = scr + kk * 33 + c4;
              d[0] = tv[i].x * sc; d[1] = tv[i].y * sc; d[2] = tv[i].z * sc; d[3] = tv[i].w * sc; } }
        asm volatile("s_waitcnt lgkmcnt(0)" ::: "memory");
        const int c = lane & 7;
#pragma unroll
        for (int j = 0; j < 4; ++j) { const int n = (lane >> 3) + 8 * j; const LAS float* s = scr + (8 * c) * 33 + n;
            u32x4 o; o.x = pk2(s[0 * 33], s[1 * 33]); o.y = pk2(s[2 * 33], s[3 * 33]); o.z = pk2(s[4 * 33], s[5 * 33]); o.w = pk2(s[6 * 33], s[7 * 33]);
            *(u32x4*)(WT + (size_t)(drow0 + n0 + n) * ldt + k0 + 8 * c) = o; }
        asm volatile("s_waitcnt lgkmcnt(0)" ::: "memory");
    }
    {
        f32x4 gv[4];
#pragma unroll
        for (int j = 0; j < 4; ++j) gv[j] = ((const f32x4*)a.g_mix_pre)[lane + 64 * j];
        bf16_t* H = (bf16_t*)(ws + WS_H); float* logf = (float*)(ws + WS_LOGF);
        f32x4 vn[4];
        if (gw < T_) { const f32x4* xr = (const f32x4*)(a.x + (size_t)gw * D_) + lane;
#pragma unroll
            for (int j = 0; j < 4; ++j) vn[j] = xr[64 * j]; }
        for (int m = gw; m < T_; m += NGW) {
            f32x4 v[4]; float ss = 0.f;
#pragma unroll
            for (int j = 0; j < 4; ++j) v[j] = vn[j];
            if (m + NGW < T_) { const f32x4* xr = (const f32x4*)(a.x + (size_t)(m + NGW) * D_) + lane;
#pragma unroll
                for (int j = 0; j < 4; ++j) vn[j] = xr[64 * j]; }
#pragma unroll
            for (int j = 0; j < 4; ++j) ss += (v[j].x * v[j].x + v[j].y * v[j].y) + (v[j].z * v[j].z + v[j].w * v[j].w);
            const float r = rsqrtf(wave_sum(ss) * (1.f / D_) + EPS);
            u32x2* o8 = (u32x2*)(H + (size_t)m * D_) + lane;
            float d0 = 0.f, d1 = 0.f, d2 = 0.f, d3 = 0.f, d4 = 0.f, d5 = 0.f, d6 = 0.f, d7 = 0.f;
#pragma unroll
            for (int j = 0; j < 4; ++j) { v[j] = v[j] * r * gv[j]; u32x2 w; w.x = pk2(v[j].x, v[j].y); w.y = pk2(v[j].z, v[j].w); o8[64 * j] = w;
#pragma unroll
                for (int e = 0; e < 4; ++e) { const int k = 4 * lane + 256 * j + e; const f32x4 w0 = *(const LAS f32x4*)(wf + k * 8), w1 = *(const LAS f32x4*)(wf + k * 8 + 4); const float hv = v[j][e];
                    d0 += hv * w0.x; d1 += hv * w0.y; d2 += hv * w0.z; d3 += hv * w0.w; d4 += hv * w1.x; d5 += hv * w1.y; d6 += hv * w1.z; d7 += hv * w1.w; } }
            d0 = wave_sum(d0); d1 = wave_sum(d1); d2 = wave_sum(d2); d3 = wave_sum(d3); d4 = wave_sum(d4); d5 = wave_sum(d5); d6 = wave_sum(d6); d7 = wave_sum(d7);
            if (lane < 8) { float z = lane == 0 ? d0 : lane == 1 ? d1 : lane == 2 ? d2 : lane == 3 ? d3 : lane == 4 ? d4 : lane == 5 ? d5 : lane == 6 ? d6 : d7;
                z += a.b_fgt[lane]; const float lf = z >= 0.f ? -log1pf(expf(-z)) : z - log1pf(expf(z)); logf[(size_t)m * 8 + lane] = lf; }
        }
    }
    {
        bf16_t* MN = (bf16_t*)(ws + WS_MEMN);
        for (int m = gw; m < MT; m += NGW) {
            const f32x4* xr = (const f32x4*)(a.mem + (size_t)m * D_) + lane;
            f32x4 v[4]; float ss = 0.f;
#pragma unroll
            for (int j = 0; j < 4; ++j) { v[j] = xr[64 * j]; ss += (v[j].x * v[j].x + v[j].y * v[j].y) + (v[j].z * v[j].z + v[j].w * v[j].w); }
            const float r = rsqrtf(wave_sum(ss) * (1.f / D_) + EPS);
            u32x2* o8 = (u32x2*)(MN + (size_t)m * D_) + lane;
#pragma unroll
            for (int j = 0; j < 4; ++j) { const f32x4 g = ((const f32x4*)a.g_mem_kv)[lane + 64 * j]; const f32x4 h = v[j] * r * g; u32x2 w; w.x = pk2(h.x, h.y); w.y = pk2(h.z, h.w); o8[64 * j] = w; }
        }
    }
}

__device__ __forceinline__ void cumsum_bh(const Args& a, LAS unsigned char* lds, int bh, int tid, int lane, int wid) {
    const float* logf = (const float*)(a.ws + WS_LOGF); float* c2 = (float*)(a.ws + WS_C2);
    const int b = bh >> 3, h = bh & 7;
    float v0 = logf[((size_t)b * S_ + 4 * tid + 0) * 8 + h], v1 = logf[((size_t)b * S_ + 4 * tid + 1) * 8 + h], v2 = logf[((size_t)b * S_ + 4 * tid + 2) * 8 + h], v3 = logf[((size_t)b * S_ + 4 * tid + 3) * 8 + h];
    v1 += v0; v2 += v1; v3 += v2;
    float incl = v3;
#pragma unroll
    for (int o = 1; o < 64; o <<= 1) { const float t = __shfl_up(incl, o); if (lane >= o) incl += t; }
    LAS float* wt = (LAS float*)(lds);
    __syncthreads();
    if (lane == 63) wt[wid] = incl;
    __syncthreads();
    float pre = incl - v3;
#pragma unroll
    for (int w = 0; w < 8; ++w) if (w < wid) pre += wt[w];
    f32x4 o; o.x = (pre + v0) * LOG2E; o.y = (pre + v1) * LOG2E; o.z = (pre + v2) * LOG2E; o.w = (pre + v3) * LOG2E;
    *(f32x4*)(c2 + (size_t)bh * S_ + 4 * tid) = o;
    __syncthreads();
}

constexpr int KP = 144, VP = 136;
constexpr int A_K0 = 0, A_V0 = 2 * 64 * KP, A_NC = A_V0 + 2 * 64 * VP, A_TB = A_NC + 8192;
__device__ __forceinline__ int crow(int r, int hi) { return (r & 3) + 8 * (r >> 2) + 4 * hi; }

template <int MODE  >
__device__ __forceinline__ void attn_unit(const Args& a, LAS unsigned char* lds, int b, int h, int qb, int tid, int lane, int wid) {
    const bf16_t* QK = (const bf16_t*)(a.ws + WS_QK); const bf16_t* VT = (const bf16_t*)(a.ws + WS_VT);
    bf16_t* Y = (bf16_t*)(a.ws + (MODE == 0 ? WS_YF : WS_YC));
    const int r32 = lane & 31, hi = lane >> 5;
    const int qcol = MODE == 0 ? 0 : 1024, kcol = qcol + 512, vrow0 = MODE == 0 ? 0 : 512;
    const size_t tok0 = (size_t)b * S_;
    const int q = qb * 256 + wid * 32 + r32;
    LAS float* nc = (LAS float*)(lds + A_NC); LAS float* tb = (LAS float*)(lds + A_TB);
    float cq = 0.f;
    if (MODE == 0) {
        const float* c2 = (const float*)(a.ws + WS_C2) + (size_t)(b * 8 + h) * S_;
        for (int i = tid; i < (qb + 1) * 256; i += 512) nc[i] = -c2[i];
        cq = c2[q];
    } else {
        const float* rb = a.rel_bias + (size_t)h * 257; const float base = rb[256];
        if (tid < 257) tb[tid] = (rb[tid] - base) * LOG2E;
    }
    bf16x8 qf[4];
    { const bf16_t* qp = QK + (tok0 + q) * 2048 + qcol + h * 64 + hi * 8;
#pragma unroll
      for (int d0 = 0; d0 < 4; ++d0) qf[d0] = *(const bf16x8*)(qp + d0 * 16); }
    const int t_lo = MODE == 0 ? 0 : (4 * qb - 8 > 0 ? 4 * qb - 8 : 0), t_hi = 4 * qb + 3;
    const int kr = tid >> 3, kc = tid & 7;
    const bf16_t* ksrc = QK + (tok0 + kr) * 2048 + kcol + h * 64 + kc * 8;
    const bf16_t* vsrc = VT + (size_t)(vrow0 + h * 64 + kr) * T_ + tok0 + kc * 8;
    const int kdst = A_K0 + kr * KP + kc * 16, vdst = A_V0 + kr * VP + kc * 16;
    u32x4 kreg = *(const u32x4*)(ksrc + (size_t)t_lo * 64 * 2048), vreg = *(const u32x4*)(vsrc + (size_t)t_lo * 64);
    *(LAS u32x4*)(lds + kdst) = kreg; *(LAS u32x2*)(lds + vdst) = (u32x2){vreg.x, vreg.y}; *(LAS u32x2*)(lds + vdst + 8) = (u32x2){vreg.z, vreg.w};
    __syncthreads();
    float m = -INFINITY, l = 0.f; f32x16 o0 = {}, o1 = {};
    const int q0w = qb * 256 + wid * 32, cw = 4 * qb + (wid >> 1);
    for (int t = t_lo; t <= t_hi; ++t) {
        const int cur = (t - t_lo) & 1;
        if (t < t_hi) { kreg = *(const u32x4*)(ksrc + (size_t)(t + 1) * 64 * 2048); vreg = *(const u32x4*)(vsrc + (size_t)(t + 1) * 64); }
        bool part;
        if (MODE == 0) part = (64 * t <= q0w + 31); else part = (t <= cw && t >= cw - 8);
        if (part) {
            const LAS unsigned char* Kb = lds + A_K0 + cur * 64 * KP; const LAS unsigned char* Vb = lds + A_V0 + cur * 64 * VP;
            f32x16 s0, s1;
#pragma unroll
            for (int r = 0; r < 16; ++r) { s0[r] = cq; s1[r] = cq; }
#pragma unroll
            for (int d0 = 0; d0 < 4; ++d0) {
                const bf16x8 k0f = *(const LAS bf16x8*)(Kb + r32 * KP + d0 * 32 + hi * 16), k1f = *(const LAS bf16x8*)(Kb + (r32 + 32) * KP + d0 * 32 + hi * 16);
                s0 = __builtin_amdgcn_mfma_f32_32x32x16_bf16(k0f, qf[d0], s0, 0, 0, 0); s1 = __builtin_amdgcn_mfma_f32_32x32x16_bf16(k1f, qf[d0], s1, 0, 0, 0);
            }
            if (MODE == 0) {
#pragma unroll
                for (int g = 0; g < 4; ++g) { const f32x4 n0 = *(const LAS f32x4*)(nc + 64 * t + 8 * g + 4 * hi), n1 = *(const LAS f32x4*)(nc + 64 * t + 32 + 8 * g + 4 * hi);
#pragma unroll
                    for (int e = 0; e < 4; ++e) { s0[4 * g + e] += n0[e]; s1[4 * g + e] += n1[e]; } }
                if (64 * t + 63 > q0w) {
#pragma unroll
                    for (int r = 0; r < 16; ++r) { const int kv = 64 * t + crow(r, hi); if (kv > q) s0[r] = -INFINITY; if (kv + 32 > q) s1[r] = -INFINITY; }
                }
            } else {
                if (t >= cw - 2) {
#pragma unroll
                    for (int r = 0; r < 16; ++r) { const int rel = q - (64 * t + crow(r, hi)); int i0 = rel < 128 ? rel : 128; int i1 = rel - 32 < 128 ? rel - 32 : 128;
                        s0[r] += tb[i0 + 128]; s1[r] += tb[i1 + 128]; }
                }
            }
            float mx = fmaxf(s0[0], s1[0]);
#pragma unroll
            for (int r = 1; r < 16; ++r) mx = fmaxf(mx, fmaxf(s0[r], s1[r]));
            mx = fmaxf(mx, __shfl_xor(mx, 32));
            const float mn = fmaxf(m, mx), alpha = __builtin_amdgcn_exp2f(m - mn); m = mn;
            float ps = 0.f;
#pragma unroll
            for (int r = 0; r < 16; ++r) { s0[r] = __builtin_amdgcn_exp2f(s0[r] - mn); s1[r] = __builtin_amdgcn_exp2f(s1[r] - mn); ps += s0[r] + s1[r]; }
            l = l * alpha + ps;
#pragma unroll
            for (int r = 0; r < 16; ++r) { o0[r] *= alpha; o1[r] *= alpha; }
            bf16x8 pa[2][2];
            { u32x4 w;
              w.x = pk2(s0[0], s0[1]); w.y = pk2(s0[2], s0[3]); w.z = pk2(s0[4], s0[5]); w.w = pk2(s0[6], s0[7]); pa[0][0] = __builtin_bit_cast(bf16x8, w);
              w.x = pk2(s0[8], s0[9]); w.y = pk2(s0[10], s0[11]); w.z = pk2(s0[12], s0[13]); w.w = pk2(s0[14], s0[15]); pa[0][1] = __builtin_bit_cast(bf16x8, w);
              w.x = pk2(s1[0], s1[1]); w.y = pk2(s1[2], s1[3]); w.z = pk2(s1[4], s1[5]); w.w = pk2(s1[6], s1[7]); pa[1][0] = __builtin_bit_cast(bf16x8, w);
              w.x = pk2(s1[8], s1[9]); w.y = pk2(s1[10], s1[11]); w.z = pk2(s1[12], s1[13]); w.w = pk2(s1[14], s1[15]); pa[1][1] = __builtin_bit_cast(bf16x8, w); }
#pragma unroll
            for (int sub = 0; sub < 2; ++sub)
#pragma unroll
                for (int hf = 0; hf < 2; ++hf) {
                    const int kb2 = (32 * sub + 16 * hf + 4 * hi) * 2;
                    const u32x2 a0 = *(const LAS u32x2*)(Vb + r32 * VP + kb2), a1 = *(const LAS u32x2*)(Vb + r32 * VP + kb2 + 16);
                    const u32x2 b0 = *(const LAS u32x2*)(Vb + (r32 + 32) * VP + kb2), b1 = *(const LAS u32x2*)(Vb + (r32 + 32) * VP + kb2 + 16);
                    const bf16x8 va = __builtin_bit_cast(bf16x8, (u32x4){a0.x, a0.y, a1.x, a1.y}), vb = __builtin_bit_cast(bf16x8, (u32x4){b0.x, b0.y, b1.x, b1.y});
                    o0 = __builtin_amdgcn_mfma_f32_32x32x16_bf16(va, pa[sub][hf], o0, 0, 0, 0); o1 = __builtin_amdgcn_mfma_f32_32x32x16_bf16(vb, pa[sub][hf], o1, 0, 0, 0);
                }
        }
        if (t < t_hi) { const int nb = (cur ^ 1);
            *(LAS u32x4*)(lds + kdst + nb * 64 * KP) = kreg; *(LAS u32x2*)(lds + vdst + nb * 64 * VP) = (u32x2){vreg.x, vreg.y}; *(LAS u32x2*)(lds + vdst + nb * 64 * VP + 8) = (u32x2){vreg.z, vreg.w}; }
        __syncthreads();
    }
    l += __shfl_xor(l, 32);
    const float inv = 1.f / l;
    bf16_t* yp = Y + (tok0 + q) * 512 + h * 64 + 4 * hi;
#pragma unroll
    for (int g = 0; g < 4; ++g) {
        u32x2 w; w.x = pk2(o0[4 * g] * inv, o0[4 * g + 1] * inv); w.y = pk2(o0[4 * g + 2] * inv, o0[4 * g + 3] * inv); *(u32x2*)(yp + 8 * g) = w;
        w.x = pk2(o1[4 * g] * inv, o1[4 * g + 1] * inv); w.y = pk2(o1[4 * g + 2] * inv, o1[4 * g + 3] * inv); *(u32x2*)(yp + 32 + 8 * g) = w;
    }
}

constexpr int XVP = 520;
constexpr int XK_BYTES = 256 * KP, XV_BYTES = 32 * XVP, XV_OFF = 2 * XK_BYTES;
__device__ __forceinline__ void xattn_unit(const Args& a, LAS unsigned char* lds, int b, int hd, int qb, int tid, int lane, int wid) {
    const bf16_t* Q2 = (const bf16_t*)(a.ws + WS_Q2); const bf16_t* MK = (const bf16_t*)(a.ws + WS_MEMK); const bf16_t* MVT = (const bf16_t*)(a.ws + WS_MEMVT);
    bf16_t* O2 = (bf16_t*)(a.ws + WS_O2);
    const int r32 = lane & 31, hi = lane >> 5;
    const size_t tok = (size_t)b * S_ + qb * 256 + wid * 32 + r32;
    const bf16_t* ksrc = MK + (size_t)(b * 256 + (tid >> 3)) * 1024 + hd * 256 + (tid & 7) * 8;
    const int kdst = (tid >> 3) * KP + (tid & 7) * 16;
    const bf16_t* vsrc = MVT + (size_t)(hd * 256 + (tid >> 5)) * MT + b * 256 + (tid & 31) * 8;
    const int vdst = XV_OFF + (tid >> 5) * XVP + (tid & 31) * 16;
    u32x4 kr[4], vr[2];
#pragma unroll
    for (int i = 0; i < 4; ++i) kr[i] = *(const u32x4*)(ksrc + (size_t)i * 64 * 1024);
#pragma unroll
    for (int i = 0; i < 4; ++i) *(LAS u32x4*)(lds + kdst + i * 64 * KP) = kr[i];
    __syncthreads();
    f32x16 s[8];
#pragma unroll
    for (int j = 0; j < 8; ++j) s[j] = (f32x16){};
#pragma unroll
    for (int dc = 0; dc < 4; ++dc) {
        if (dc < 3) {
#pragma unroll
            for (int i = 0; i < 4; ++i) kr[i] = *(const u32x4*)(ksrc + (size_t)i * 64 * 1024 + (dc + 1) * 64);
        }
        bf16x8 qf[4];
#pragma unroll
        for (int d0 = 0; d0 < 4; ++d0) qf[d0] = *(const bf16x8*)(Q2 + tok * 1024 + hd * 256 + dc * 64 + d0 * 16 + hi * 8);
        const LAS unsigned char* Kb = lds + (dc & 1) * XK_BYTES;
#pragma unroll
        for (int d0 = 0; d0 < 4; ++d0)
#pragma unroll
            for (int j = 0; j < 8; ++j) { const bf16x8 kf = *(const LAS bf16x8*)(Kb + (32 * j + r32) * KP + d0 * 32 + hi * 16); s[j] = __builtin_amdgcn_mfma_f32_32x32x16_bf16(kf, qf[d0], s[j], 0, 0, 0); }
        if (dc < 3) {
#pragma unroll
            for (int i = 0; i < 4; ++i) *(LAS u32x4*)(lds + ((dc + 1) & 1) * XK_BYTES + kdst + i * 64 * KP) = kr[i];
        } else {
#pragma unroll
            for (int i = 0; i < 2; ++i) vr[i] = *(const u32x4*)(vsrc + (size_t)i * 16 * MT);
#pragma unroll
            for (int i = 0; i < 2; ++i) { *(LAS u32x2*)(lds + vdst + i * 16 * XVP) = (u32x2){vr[i].x, vr[i].y}; *(LAS u32x2*)(lds + vdst + i * 16 * XVP + 8) = (u32x2){vr[i].z, vr[i].w}; }
        }
        __syncthreads();
    }
    float mx = s[0][0];
#pragma unroll
    for (int j = 0; j < 8; ++j)
#pragma unroll
        for (int r = 0; r < 16; ++r) mx = fmaxf(mx, s[j][r]);
    mx = fmaxf(mx, __shfl_xor(mx, 32));
    float l = 0.f;
    bf16x8 pa[8][2];
#pragma unroll
    for (int j = 0; j < 8; ++j) {
#pragma unroll
        for (int r = 0; r < 16; ++r) { s[j][r] = __builtin_amdgcn_exp2f(s[j][r] - mx); l += s[j][r]; }
        u32x4 w;
        w.x = pk2(s[j][0], s[j][1]); w.y = pk2(s[j][2], s[j][3]); w.z = pk2(s[j][4], s[j][5]); w.w = pk2(s[j][6], s[j][7]); pa[j][0] = __builtin_bit_cast(bf16x8, w);
        w.x = pk2(s[j][8], s[j][9]); w.y = pk2(s[j][10], s[j][11]); w.z = pk2(s[j][12], s[j][13]); w.w = pk2(s[j][14], s[j][15]); pa[j][1] = __builtin_bit_cast(bf16x8, w);
    }
    l += __shfl_xor(l, 32);
    const float inv = 1.f / l;
#pragma unroll 1
    for (int ds = 0; ds < 8; ++ds) {
        if (ds < 7) {
#pragma unroll
            for (int i = 0; i < 2; ++i) vr[i] = *(const u32x4*)(vsrc + (size_t)(i * 16 + (ds + 1) * 32) * MT);
        }
        const LAS unsigned char* Vb = lds + XV_OFF + (ds & 1) * XV_BYTES;
        f32x16 o = {};
#pragma unroll
        for (int j = 0; j < 8; ++j)
#pragma unroll
            for (int hf = 0; hf < 2; ++hf) { const int kb2 = (32 * j + 16 * hf + 4 * hi) * 2;
                const u32x2 a0 = *(const LAS u32x2*)(Vb + r32 * XVP + kb2), a1 = *(const LAS u32x2*)(Vb + r32 * XVP + kb2 + 16);
                const bf16x8 va = __builtin_bit_cast(bf16x8, (u32x4){a0.x, a0.y, a1.x, a1.y});
                o = __builtin_amdgcn_mfma_f32_32x32x16_bf16(va, pa[j][hf], o, 0, 0, 0); }
        bf16_t* op = O2 + tok * 1024 + hd * 256 + ds * 32 + 4 * hi;
#pragma unroll
        for (int g = 0; g < 4; ++g) { u32x2 w; w.x = pk2(o[4 * g] * inv, o[4 * g + 1] * inv); w.y = pk2(o[4 * g + 2] * inv, o[4 * g + 3] * inv); *(u32x2*)(op + 8 * g) = w; }
        if (ds < 7) {
#pragma unroll
            for (int i = 0; i < 2; ++i) { *(LAS u32x2*)(lds + vdst + ((ds + 1) & 1) * XV_BYTES + i * 16 * XVP) = (u32x2){vr[i].x, vr[i].y}; *(LAS u32x2*)(lds + vdst + ((ds + 1) & 1) * XV_BYTES + i * 16 * XVP + 8) = (u32x2){vr[i].z, vr[i].w}; }
        }
        __syncthreads();
    }
}

template <bool TWO, bool NEXT>
__device__ __forceinline__ void row_pass(const Args& a, const float* xin, const bf16_t* ya, const bf16_t* yb, const float* g_post, const float* g_pre, int lane, int gw, int NGW) {
    const bf16_t* YF = (const bf16_t*)(a.ws + WS_YF); const bf16_t* YC = (const bf16_t*)(a.ws + WS_YC); bf16_t* H = (bf16_t*)(a.ws + WS_H);
    f32x4 gp[4], gn[4];
#pragma unroll
    for (int j = 0; j < 4; ++j) { gp[j] = ((const f32x4*)g_post)[lane + 64 * j]; if (NEXT) gn[j] = ((const f32x4*)g_pre)[lane + 64 * j]; }
    for (int m = gw; m < T_; m += NGW) {
        float rf = 1.f, rc = 1.f;
        if (TWO) {
            const u32x4 f = *((const u32x4*)(YF + (size_t)m * 512) + lane), c = *((const u32x4*)(YC + (size_t)m * 512) + lane);
            float sf = 0.f, sc = 0.f;
#pragma unroll
            for (int e = 0; e < 4; ++e) { const float f0 = bflo(f[e]), f1 = bfhi(f[e]), c0 = bflo(c[e]), c1 = bfhi(c[e]); sf += f0 * f0 + f1 * f1; sc += c0 * c0 + c1 * c1; }
            rf = rsqrtf(wave_sum(sf) * (1.f / 512.f) + EPS); rc = rsqrtf(wave_sum(sc) * (1.f / 512.f) + EPS);
        }
        f32x4 y[4]; float ss = 0.f;
#pragma unroll
        for (int j = 0; j < 4; ++j) {
            const u32x2 p = *((const u32x2*)(ya + (size_t)m * D_) + lane + 64 * j);
            y[j] = (f32x4){bflo(p.x), bfhi(p.x), bflo(p.y), bfhi(p.y)};
            if (TWO) { const u32x2 p2 = *((const u32x2*)(yb + (size_t)m * D_) + lane + 64 * j); y[j] = y[j] * rf + (f32x4){bflo(p2.x), bfhi(p2.x), bflo(p2.y), bfhi(p2.y)} * rc; }
            ss += (y[j].x * y[j].x + y[j].y * y[j].y) + (y[j].z * y[j].z + y[j].w * y[j].w);
        }
        const float r = rsqrtf(wave_sum(ss) * (1.f / D_) + EPS);
        const f32x4* xr = (const f32x4*)(xin + (size_t)m * D_) + lane; f32x4* xo = (f32x4*)(a.out + (size_t)m * D_) + lane;
        float s2 = 0.f;
#pragma unroll
        for (int j = 0; j < 4; ++j) { y[j] = xr[64 * j] + y[j] * r * gp[j]; xo[64 * j] = y[j]; s2 += (y[j].x * y[j].x + y[j].y * y[j].y) + (y[j].z * y[j].z + y[j].w * y[j].w); }
        if (NEXT) {
            const float r2 = rsqrtf(wave_sum(s2) * (1.f / D_) + EPS);
            u32x2* o8 = (u32x2*)(H + (size_t)m * D_) + lane;
#pragma unroll
            for (int j = 0; j < 4; ++j) { const f32x4 h = y[j] * r2 * gn[j]; u32x2 w; w.x = pk2(h.x, h.y); w.y = pk2(h.z, h.w); o8[64 * j] = w; }
        }
    }
}

#define RLX_AGENT __ATOMIC_RELAXED, __HIP_MEMORY_SCOPE_AGENT
#define XB_TMO      128
#define XB_XCNT(j)  (256  + 64 * (j))
#define XB_XSUB(j)  (1280 + 64 * (j))
#define XB_XGEN(j)  (2304 + 64 * (j))
#define XB_TOP      3328
#define XB_TOPGEN   3392
#define XCD_BAR_WORDS 3456
#define XB_SPIN_CAP (1u << 18)

__device__ __forceinline__ unsigned xb_ld(unsigned* p)              { return __hip_atomic_load(p, __ATOMIC_RELAXED, __HIP_MEMORY_SCOPE_AGENT); }
__device__ __forceinline__ unsigned xb_add(unsigned* p, unsigned v) { return __hip_atomic_fetch_add(p, v, __ATOMIC_RELAXED, __HIP_MEMORY_SCOPE_AGENT); }
__device__ __forceinline__ unsigned xb_xcc_id() { return (unsigned)__builtin_amdgcn_s_getreg((3 << 11) | 20) & 0xFu; }
#define XB_SPIN(cond, bar) do { unsigned _sp = 0; while (cond) { __builtin_amdgcn_s_sleep(1); \
    if ((++_sp & 255u) == 0u) { if (xb_ld(&(bar)[XB_TMO])) break; if (_sp > XB_SPIN_CAP) { atomicAdd(&(bar)[XB_TMO], 1u); break; } } } } while (0)

struct XcdBarrier {
    unsigned* bar; unsigned x;
    volatile LAS unsigned* st;
};

__device__ __forceinline__ XcdBarrier xcd_barrier_post(unsigned* bar, volatile LAS unsigned* st) {
    XcdBarrier b; b.bar = bar; b.x = xb_xcc_id(); b.st = st;
    if (threadIdx.x == 0) (void)xb_add(&bar[XB_XCNT(b.x)], 1u);
    return b;
}
__device__ __forceinline__ void xcd_barrier_complete(unsigned* bar, unsigned x, unsigned& nloc, unsigned& nx) {
    const unsigned G = gridDim.x * gridDim.y * gridDim.z;
    unsigned sum, cnt, mine, sp = 0u;
    for (;;) {
        sum = 0u; cnt = 0u; mine = 0u;
#pragma unroll
        for (unsigned j = 0; j < 16; ++j) { const unsigned c = xb_ld(&bar[XB_XCNT(j)]); sum += c; cnt += (c > 0u) ? 1u : 0u; mine = (j == x) ? c : mine; }
        if (sum == G) break;
        __builtin_amdgcn_s_sleep(1);
        if ((++sp & 255u) == 0u) { if (xb_ld(&bar[XB_TMO])) break; if (sp > XB_SPIN_CAP) { atomicAdd(&bar[XB_TMO], 1u); break; } }
    }
    nloc = mine > 0u ? mine : 1u; nx = cnt > 0u ? cnt : 1u;
}

__device__ __forceinline__ void xcd_barrier(const XcdBarrier& b) {
    asm volatile("s_waitcnt vmcnt(0)" ::: "memory");
    __syncthreads();
    if (threadIdx.x == 0) {
        unsigned* bar = b.bar;
        __builtin_amdgcn_s_waitcnt(0);
        unsigned nloc = b.st[0], nx = b.st[1];
        if (nloc == 0u) { xcd_barrier_complete(bar, b.x, nloc, nx); b.st[0] = nloc; b.st[1] = nx; }
        const unsigned old = xb_add(&bar[XB_XSUB(b.x)], 1u);
        const unsigned gen = old / nloc;
        if (old + 1u == (gen + 1u) * nloc) {
            __builtin_amdgcn_fence(__ATOMIC_RELEASE, "agent");
            asm volatile("s_waitcnt vmcnt(0)" ::: "memory");
            const unsigned og = xb_add(&bar[XB_TOP], 1u);
            const unsigned tg = og / nx;
            if (og + 1u == (tg + 1u) * nx) xb_add(&bar[XB_TOPGEN], 1u);
            else XB_SPIN(xb_ld(&bar[XB_TOPGEN]) == tg, bar);
            __builtin_amdgcn_fence(__ATOMIC_ACQUIRE, "agent");
            xb_add(&bar[XB_XGEN(b.x)], 1u);
            asm volatile("s_waitcnt vmcnt(0)" ::: "memory");
        } else {
            XB_SPIN(xb_ld(&bar[XB_XGEN(b.x)]) == gen, bar);
            __builtin_amdgcn_fence(__ATOMIC_ACQUIRE, "agent");
            asm volatile("s_waitcnt vmcnt(0)" ::: "memory");
        }
    }
    __syncthreads();
}

template <int ACT>
__device__ __forceinline__ void run_gemm(LAS unsigned char* lds, const bf16_t* A, const bf16_t* Bt, int M, int N, int K, bf16_t* O, int ldc, int G, int c) {
    pg8::Gemm g{A, Bt, M, N, K}; pg8::StaticOrder S; S.init(M, N, G, c);
    pg8::EpiStore<ACT> E{O, ldc};
    pg8::gemm_phase<pg8::EpiStore<ACT>, pg8::StaticOrder, PG8_ALIGN, PG8_SP2>(lds, g, S, E);
    __syncthreads();
}

__global__ void __launch_bounds__(512) fwd_kernel(Args a) {
    extern __shared__ __attribute__((aligned(16))) unsigned char lds_raw[];
    LAS unsigned char* lds = (LAS unsigned char*)lds_raw;
    const int tid = threadIdx.x, lane = tid & 63, wid = __builtin_amdgcn_readfirstlane(tid >> 6);
    const int G = gridDim.x, bx = blockIdx.x;
    const int gw = bx * 8 + wid, NGW = G * 8;
    unsigned char* ws = a.ws;
    const int lo = a.ph_lo, hi = a.ph_hi;
#define IN(k) (lo <= (k) && (k) < hi)
    if (tid < 2) ((LAS unsigned*)(lds + 131072 + 16))[tid] = 0u;
    __syncthreads();
    XcdBarrier xbar = xcd_barrier_post((unsigned*)(ws + WS_CTL) + 1024, (volatile LAS unsigned*)(lds + 131072 + 16));
#define SEAM(k) do { if (IN(k) && IN((k) + 1)) { if ((k) == 0) cg::this_grid().sync(); else xcd_barrier(xbar); } } while (0)
    bf16_t* H = (bf16_t*)(ws + WS_H);

    if (IN(0)) { p0_prep(a, lds, tid, lane, wid, gw, NGW); }
    SEAM(0);
    if (IN(1)) {
        if (bx >= 64 && bx < 128) cumsum_bh(a, lds, bx - 64, tid, lane, wid);
        run_gemm<0>(lds, H, (const bf16_t*)(ws + WS_WA), T_, 2048, 1024, (bf16_t*)(ws + WS_QK), 2048, G, bx);
        run_gemm<0>(lds, (const bf16_t*)(ws + WS_WV), H, 1024, T_, 1024, (bf16_t*)(ws + WS_VT), T_, G, bx);
    }
    SEAM(1);
    if (IN(2)) {
        run_gemm<0>(lds, (const bf16_t*)(ws + WS_MEMN), (const bf16_t*)(ws + WS_WMK), MT, 1024, 1024, (bf16_t*)(ws + WS_MEMK), 1024, G, bx);
        run_gemm<0>(lds, (const bf16_t*)(ws + WS_WMV), (const bf16_t*)(ws + WS_MEMN), 1024, MT, 1024, (bf16_t*)(ws + WS_MEMVT), MT, G, (bx + G - 32) % G);
        unsigned* ctr = (unsigned*)(ws + WS_CTL);
        LAS int* uq = (LAS int*)(lds + 131072);
        for (;;) {
            if (tid == 0) *uq = (int)atomicAdd(ctr, 1u);
            __syncthreads();
            int u = *uq;
            __syncthreads();
            if (u >= 1024) break;
            int mode, qb, bh;
            if (u < 320) { mode = 0; qb = 7 - (u >> 6); bh = u & 63; }
            else if (u < 704) { const int j = u - 320; mode = 1; qb = 2 + (j >> 6); bh = j & 63; }
            else if (u < 768) { mode = 0; qb = 2; bh = u & 63; }
            else if (u < 832) { mode = 0; qb = 1; bh = u & 63; }
            else if (u < 896) { mode = 1; qb = 1; bh = u & 63; }
            else if (u < 960) { mode = 0; qb = 0; bh = u & 63; }
            else { mode = 1; qb = 0; bh = u & 63; }
            if (mode == 0) attn_unit<0>(a, lds, bh >> 3, bh & 7, qb, tid, lane, wid);
            else attn_unit<1>(a, lds, bh >> 3, bh & 7, qb, tid, lane, wid);
        }
    }
    SEAM(2);
    if (IN(3)) {
        run_gemm<0>(lds, (const bf16_t*)(ws + WS_YF), (const bf16_t*)(ws + WS_WOF), T_, 1024, 512, (bf16_t*)(ws + WS_Y1A), 1024, G, bx);
        run_gemm<0>(lds, (const bf16_t*)(ws + WS_YC), (const bf16_t*)(ws + WS_WOC), T_, 1024, 512, (bf16_t*)(ws + WS_Y1B), 1024, G, bx);
    }
    SEAM(3);
    if (IN(4)) row_pass<true, true>(a, a.x, (const bf16_t*)(ws + WS_Y1A), (const bf16_t*)(ws + WS_Y1B), a.g_mix_post, a.g_mem_pre, lane, gw, NGW);
    SEAM(4);
    if (IN(5)) run_gemm<0>(lds, H, (const bf16_t*)(ws + WS_WMQ), T_, 1024, 1024, (bf16_t*)(ws + WS_Q2), 1024, G, bx);
    SEAM(5);
    if (IN(6)) { for (int u = bx; u < 256; u += G) xattn_unit(a, lds, u >> 5, (u >> 3) & 3, u & 7, tid, lane, wid); }
    SEAM(6);
    if (IN(7)) run_gemm<0>(lds, (const bf16_t*)(ws + WS_O2), (const bf16_t*)(ws + WS_WMO), T_, 1024, 1024, (bf16_t*)(ws + WS_Y2), 1024, G, bx);
    SEAM(7);
    if (IN(8)) row_pass<false, true>(a, a.out, (const bf16_t*)(ws + WS_Y2), nullptr, a.g_mem_post, a.g_ff_pre, lane, gw, NGW);
    SEAM(8);
    if (IN(9)) run_gemm<2>(lds, H, (const bf16_t*)(ws + WS_WF1), T_, FF, 1024, (bf16_t*)(ws + WS_FFH), FF, G, bx);
    SEAM(9);
    if (IN(10)) run_gemm<0>(lds, (const bf16_t*)(ws + WS_FFH), (const bf16_t*)(ws + WS_WF2), T_, 1024, FF, (bf16_t*)(ws + WS_Y3), 1024, G, bx);
    SEAM(10);
    if (IN(11)) row_pass<false, false>(a, a.out, (const bf16_t*)(ws + WS_Y3), nullptr, a.g_ff_post, nullptr, lane, gw, NGW);
#undef IN
#undef SEAM
}

constexpr int N_PHASES = 12;

extern "C" void kernel_launch(void* const* d_in, const int* in_sizes, int n_in, void* d_out, int out_size, void* d_ws, size_t ws_size, hipStream_t stream) {
    static int grid = 0;
    if (grid == 0) {
        if (n_in != 21 || out_size != T_ * D_ || ws_size < WS_END) { fprintf(stderr, "kernel_launch: unexpected shapes (n_in %d out %d ws %zu)\n", n_in, out_size, ws_size); grid = -1; return; }
        int dev = 0, cus = 0, per_cu = 0;
        hipGetDevice(&dev); hipDeviceGetAttribute(&cus, hipDeviceAttributeMultiprocessorCount, dev);
        if (hipFuncSetAttribute((const void*)fwd_kernel, hipFuncAttributeMaxDynamicSharedMemorySize, LDS_BYTES) != hipSuccess) { fprintf(stderr, "kernel_launch: hipFuncSetAttribute failed\n"); grid = -1; return; }
        if (hipOccupancyMaxActiveBlocksPerMultiprocessor(&per_cu, (const void*)fwd_kernel, 512, LDS_BYTES) != hipSuccess || per_cu < 1) { fprintf(stderr, "kernel_launch: occupancy query says %d\n", per_cu); per_cu = 1; }
        (void)hipGetLastError();
        grid = cus * 1;
        if (grid <= 0) grid = 256;
    }
    if (grid < 0) return;
    hipMemsetAsync((char*)d_ws + WS_CTL, 0, 65536, stream);
    Args a{};
    const float** p = (const float**)&a;
    for (int i = 0; i < 21; ++i) p[i] = (const float*)d_in[i];
    a.out = (float*)d_out; a.ws = (unsigned char*)d_ws;
#if MK_MULTI
    for (int ph = 0; ph < N_PHASES; ++ph) { const int reps = ((REP_MASK >> ph) & 1) ? 1 + REP_N : 1;
        for (int rp = 0; rp < reps; ++rp) { if (ph == 2) hipMemsetAsync((char*)d_ws + WS_CTL, 0, 65536, stream); a.ph_lo = ph; a.ph_hi = ph + 1; hipLaunchKernelGGL(fwd_kernel, dim3(grid), dim3(512), LDS_BYTES, stream, a); } }
#else
    a.ph_lo = 0; a.ph_hi = N_PHASES;
    void* args[] = {&a};
    hipError_t e = hipLaunchCooperativeKernel((const void*)fwd_kernel, dim3(grid), dim3(512), args, LDS_BYTES, stream);
    if (e != hipSuccess) fprintf(stderr, "cooperative launch failed: %s (grid %d)\n", hipGetErrorString(e), grid);
#endif
}
```
